# Optimizing an MI355X kernel written in HIP

```python
import math
import jax
import jax.numpy as jnp
from jax import lax
import numpy as np

D_MODEL = 1024
BATCH = 8
SEQ = 2048
DEPTH = 4

SSM_WIDTH = D_MODEL // 2
SSM_GROUP = 16
SSM_GROUPS = SSM_WIDTH // SSM_GROUP
SSM_STATE = 64
DT_MIN = 0.001
DT_MAX = 0.1
DIFF_HEADS = 4
DIFF_HEAD_DIM = 64
DIFF_V_DIM = 2 * DIFF_HEAD_DIM
DIFF_WIDTH = DIFF_HEADS * DIFF_V_DIM
FOX_HEADS = 8
FOX_HEAD_DIM = 64
FOX_WIDTH = FOX_HEADS * FOX_HEAD_DIM
N_BRANCH = 3
BRANCH_WIDTH = SSM_WIDTH
Q_BLOCK = 128
ROPE_THETA = 10000.0
N_EXPERT_GROUPS = 4
EXPERTS_PER_GROUP = 4
N_EXPERTS = N_EXPERT_GROUPS * EXPERTS_PER_GROUP
D_EXPERT = 256
TOP_K = 2
ALPHA = (2 * DEPTH) ** 0.25
BETA = (8 * DEPTH) ** -0.25
LN_EPS = 1e-5
RMS_EPS = 1e-6
NEG_INF = -1e30

C_SSM = SSM_WIDTH
C_DQ = C_SSM + 2 * DIFF_HEADS * DIFF_HEAD_DIM
C_DK = C_DQ + 2 * DIFF_HEADS * DIFF_HEAD_DIM
C_DV = C_DK + DIFF_WIDTH
C_FQ = C_DV + FOX_WIDTH
C_FK = C_FQ + FOX_WIDTH
C_FV = C_FK + FOX_WIDTH
C_FF = C_FV + FOX_HEADS
D_IN = C_FF + N_BRANCH * D_MODEL
SPLIT_IDX = [C_SSM, C_DQ, C_DK, C_DV, C_FQ, C_FK, C_FV, C_FF]

kernel_name = 'hybrid_s5_diffattn_fox_hiermoe_deepnorm'


def layer_norm(x, g, b):
    x32 = x.astype(jnp.float32)
    mu = jnp.mean(x32, axis=-1, keepdims=True)
    var = jnp.mean(jnp.square(x32 - mu), axis=-1, keepdims=True)
    return ((x32 - mu) * lax.rsqrt(var + LN_EPS) * g.astype(jnp.float32) + b.astype(jnp.float32)).astype(x.dtype)


def apply_rope(t, cos, sin):
    t1, t2 = jnp.split(t, 2, axis=-1)
    return t * cos + jnp.concatenate([-t2, t1], axis=-1) * sin


def to_blocks(t):
    b, s = t.shape[0], t.shape[1]
    t = t.reshape((b, s // Q_BLOCK, Q_BLOCK) + t.shape[2:])
    return jnp.moveaxis(t, 1, 0)


def from_blocks(t):
    nb, b, q = t.shape[0], t.shape[1], t.shape[2]
    return jnp.moveaxis(t, 0, 1).reshape((b, nb * q) + t.shape[3:])


def ssm_combine(e1, e2):
    a1r, a1i, b1r, b1i = e1
    a2r, a2i, b2r, b2i = e2
    ar = a2r * a1r - a2i * a1i
    ai = a2r * a1i + a2i * a1r
    br = a2r * b1r - a2i * b1i + b2r
    bi = a2r * b1i + a2i * b1r + b2i
    return (ar, ai, br, bi)


def s5_branch(u, lam_re, lam_im, log_dt, b_re, b_im, c_re, c_im, d, w_glu):
    f32 = jnp.float32
    bsz, s, _ = u.shape
    u = u.astype(f32).reshape(bsz, s, SSM_GROUPS, SSM_GROUP)
    lr = lam_re.astype(f32)
    li = lam_im.astype(f32)
    dt = jnp.exp(log_dt.astype(f32))[:, None]
    mag = jnp.exp(lr * dt)
    ang = li * dt
    ar = mag * jnp.cos(ang)
    ai = mag * jnp.sin(ang)
    er = ar - 1.0
    ei = ai
    den = lr * lr + li * li
    qr = (er * lr + ei * li) / den
    qi = (ei * lr - er * li) / den
    br = b_re.astype(f32)
    bi = b_im.astype(f32)
    bbr = qr[:, :, None] * br - qi[:, :, None] * bi
    bbi = qr[:, :, None] * bi + qi[:, :, None] * br
    bur = jnp.einsum('bsgn,gpn->bsgp', u, bbr)
    bui = jnp.einsum('bsgn,gpn->bsgp', u, bbi)
    shape = bur.shape
    elems = (jnp.broadcast_to(ar, shape), jnp.broadcast_to(ai, shape), bur, bui)
    _, _, xr, xi = lax.associative_scan(ssm_combine, elems, axis=1)
    y = (jnp.einsum('gnp,bsgp->bsgn', c_re.astype(f32), xr)
         - jnp.einsum('gnp,bsgp->bsgn', c_im.astype(f32), xi)
         + d.astype(f32).reshape(SSM_GROUPS, SSM_GROUP) * u)
    y = jax.nn.gelu(y.reshape(bsz, s, SSM_WIDTH))
    val, gate = jnp.split(y @ w_glu.astype(f32), 2, axis=-1)
    return val * jax.nn.sigmoid(gate)


def diff_attention(q, k, v, lam, lam_init, norm_g, cos, sin):
    f32 = jnp.float32
    bsz, s, _ = q.shape
    q = q.reshape(bsz, s, DIFF_HEADS, 2, DIFF_HEAD_DIM)
    k = k.reshape(bsz, s, DIFF_HEADS, 2, DIFF_HEAD_DIM)
    v = v.reshape(bsz, s, DIFF_HEADS, DIFF_V_DIM)
    cs = cos[None, :, None, None, :].astype(q.dtype)
    sn = sin[None, :, None, None, :].astype(q.dtype)
    q = apply_rope(q, cs, sn)
    k = apply_rope(k, cs, sn)
    lam32 = lam.astype(f32)
    lam_full = (jnp.exp(jnp.sum(lam32[0] * lam32[1]))
                - jnp.exp(jnp.sum(lam32[2] * lam32[3])) + lam_init)
    scale = DIFF_HEAD_DIM ** -0.5
    kpos = jnp.arange(s)

    def block(args):
        qb, i = args
        sc = jnp.einsum('bqhcd,bkhcd->bhcqk', qb, k, preferred_element_type=f32) * scale
        qpos = i * Q_BLOCK + jnp.arange(Q_BLOCK)
        mask = kpos[None, :] <= qpos[:, None]
        p = jax.nn.softmax(jnp.where(mask, sc, NEG_INF), axis=-1)
        a = p[:, :, 0] - lam_full * p[:, :, 1]
        return jnp.einsum('bhqk,bkhe->bqhe', a.astype(v.dtype), v)

    o = from_blocks(lax.map(block, (to_blocks(q), jnp.arange(s // Q_BLOCK))))
    o32 = o.astype(f32)
    o32 = o32 * lax.rsqrt(jnp.mean(jnp.square(o32), axis=-1, keepdims=True) + RMS_EPS)
    o32 = o32 * norm_g.astype(f32).reshape(DIFF_HEADS, DIFF_V_DIM) * (1.0 - lam_init)
    return o32.reshape(bsz, s, DIFF_WIDTH)


def forgetting_attention(q, k, v, f_logit, f_bias):
    f32 = jnp.float32
    bsz, s, _ = q.shape
    q = q.reshape(bsz, s, FOX_HEADS, FOX_HEAD_DIM)
    k = k.reshape(bsz, s, FOX_HEADS, FOX_HEAD_DIM)
    v = v.reshape(bsz, s, FOX_HEADS, FOX_HEAD_DIM)
    logf = jax.nn.log_sigmoid(f_logit.astype(f32) + f_bias.astype(f32))
    c = jnp.cumsum(logf, axis=1)
    c_k = jnp.transpose(c, (0, 2, 1))
    scale = FOX_HEAD_DIM ** -0.5
    kpos = jnp.arange(s)

    def block(args):
        qb, cb, i = args
        sc = jnp.einsum('bqhd,bkhd->bhqk', qb, k, preferred_element_type=f32) * scale
        sc = sc + jnp.transpose(cb, (0, 2, 1))[:, :, :, None] - c_k[:, :, None, :]
        qpos = i * Q_BLOCK + jnp.arange(Q_BLOCK)
        mask = kpos[None, :] <= qpos[:, None]
        p = jax.nn.softmax(jnp.where(mask, sc, NEG_INF), axis=-1)
        return jnp.einsum('bhqk,bkhd->bqhd', p.astype(v.dtype), v)

    o = from_blocks(lax.map(block, (to_blocks(q), to_blocks(c), jnp.arange(s // Q_BLOCK))))
    return o.reshape(bsz, s, FOX_WIDTH)


def token_mixer(h, w_in, w_branch, w_out, lam_re, lam_im, log_dt, b_re, b_im, c_re, c_im, d,
                w_glu, diff_lam, diff_g, fox_b, lam_init, cos, sin):
    bsz, s, _ = h.shape
    proj = h @ w_in
    u, dq, dk, dv, fq, fk, fv, ff, gl = jnp.split(proj, SPLIT_IDX, axis=-1)
    y_ssm = s5_branch(u, lam_re, lam_im, log_dt, b_re, b_im, c_re, c_im, d, w_glu)
    y_diff = diff_attention(dq, dk, dv, diff_lam, lam_init, diff_g, cos, sin)
    y_fox = forgetting_attention(fq, fk, fv, ff, fox_b)
    branches = jnp.stack([y_ssm, y_diff, y_fox.astype(y_ssm.dtype)], axis=2)
    proj_b = jnp.einsum('bsnw,nwd->bsnd', branches, w_branch)
    gates = jax.nn.sigmoid(gl.reshape(bsz, s, N_BRANCH, D_MODEL).astype(jnp.float32))
    merged = jnp.sum(gates * proj_b, axis=2)
    return (merged @ w_out).astype(h.dtype)


def hier_moe(x, w_g, b_g, w_e, b_e, w_gate, w_up, w_down):
    f32 = jnp.float32
    bsz, s, dm = x.shape
    t = x.reshape(-1, dm)
    pg = jax.nn.softmax((t @ w_g).astype(f32) + b_g.astype(f32), axis=-1)
    gp, gi = lax.top_k(pg, 1)
    el = ((t @ w_e).astype(f32) + b_e.astype(f32)).reshape(-1, N_EXPERT_GROUPS, EXPERTS_PER_GROUP)
    el_sel = jnp.take_along_axis(el, gi[:, :, None], axis=1)[:, 0]
    ev, ei = lax.top_k(el_sel, TOP_K)
    w = gp * jax.nn.softmax(ev, axis=-1)
    eidx = gi * EXPERTS_PER_GROUP + ei
    gate = jnp.sum(jax.nn.one_hot(eidx, N_EXPERTS, dtype=f32) * w[..., None], axis=1)
    hg = jnp.einsum('td,edf->tef', t, w_gate)
    hu = jnp.einsum('td,edf->tef', t, w_up)
    hidden = jax.nn.silu(hg) * hu * gate[:, :, None].astype(hg.dtype)
    out = jnp.einsum('tef,efd->td', hidden, w_down)
    return out.reshape(bsz, s, dm).astype(x.dtype)


def setup_inputs(seed: int = 0) -> dict:
    key = jax.random.key(seed)
    ks = jax.random.split(key, 32)
    f32 = jnp.float32

    def nrm(k, shape, scale):
        return jax.random.normal(k, shape, f32) * scale

    G, P = SSM_GROUPS, SSM_STATE
    x = nrm(ks[0], (BATCH, SEQ, D_MODEL), 1.0)
    w_in = nrm(ks[1], (DEPTH, D_MODEL, D_IN), D_MODEL ** -0.5)
    w_branch = nrm(ks[2], (DEPTH, N_BRANCH, BRANCH_WIDTH, D_MODEL), BRANCH_WIDTH ** -0.5 * BETA)
    w_out = nrm(ks[3], (DEPTH, D_MODEL, D_MODEL), D_MODEL ** -0.5 * BETA)
    ssm_lambda_re = -0.5 + nrm(ks[4], (DEPTH, G, P), 0.01)
    ssm_lambda_im = math.pi * jnp.arange(P, dtype=f32) + nrm(ks[5], (DEPTH, G, P), 0.01)
    ssm_log_dt = jax.random.uniform(ks[6], (DEPTH, G), f32, math.log(DT_MIN), math.log(DT_MAX))
    ssm_b_re = nrm(ks[7], (DEPTH, G, P, SSM_GROUP), (2 * SSM_GROUP) ** -0.5)
    ssm_b_im = nrm(ks[8], (DEPTH, G, P, SSM_GROUP), (2 * SSM_GROUP) ** -0.5)
    ssm_c_re = nrm(ks[9], (DEPTH, G, SSM_GROUP, P), P ** -0.5)
    ssm_c_im = nrm(ks[10], (DEPTH, G, SSM_GROUP, P), P ** -0.5)
    ssm_d = nrm(ks[11], (DEPTH, SSM_WIDTH), 1.0)
    ssm_w_glu = nrm(ks[12], (DEPTH, SSM_WIDTH, 2 * SSM_WIDTH), SSM_WIDTH ** -0.5)
    diff_lambda = nrm(ks[13], (DEPTH, 4, DIFF_HEAD_DIM), 0.1)
    diff_norm_g = 1.0 + nrm(ks[14], (DEPTH, DIFF_WIDTH), 0.05)
    fox_f_bias = jax.random.uniform(ks[15], (DEPTH, FOX_HEADS), f32, 1.0, 4.0)
    ln1_g = 1.0 + nrm(ks[16], (DEPTH, D_MODEL), 0.05)
    ln1_b = nrm(ks[17], (DEPTH, D_MODEL), 0.02)
    moe_w_group = nrm(ks[18], (DEPTH, D_MODEL, N_EXPERT_GROUPS), D_MODEL ** -0.5)
    moe_b_group = nrm(ks[19], (DEPTH, N_EXPERT_GROUPS), 0.01)
    moe_w_expert = nrm(ks[20], (DEPTH, D_MODEL, N_EXPERTS), D_MODEL ** -0.5)
    moe_b_expert = nrm(ks[21], (DEPTH, N_EXPERTS), 0.01)
    moe_w_gate = nrm(ks[22], (DEPTH, N_EXPERTS, D_MODEL, D_EXPERT), D_MODEL ** -0.5)
    moe_w_up = nrm(ks[23], (DEPTH, N_EXPERTS, D_MODEL, D_EXPERT), D_MODEL ** -0.5)
    moe_w_down = nrm(ks[24], (DEPTH, N_EXPERTS, D_EXPERT, D_MODEL), D_EXPERT ** -0.5 * BETA)
    ln2_g = 1.0 + nrm(ks[25], (DEPTH, D_MODEL), 0.05)
    ln2_b = nrm(ks[26], (DEPTH, D_MODEL), 0.02)
    return {'x': x, 'w_in': w_in, 'w_branch': w_branch, 'w_out': w_out,
            'ssm_lambda_re': ssm_lambda_re, 'ssm_lambda_im': ssm_lambda_im, 'ssm_log_dt': ssm_log_dt,
            'ssm_b_re': ssm_b_re, 'ssm_b_im': ssm_b_im, 'ssm_c_re': ssm_c_re, 'ssm_c_im': ssm_c_im,
            'ssm_d': ssm_d, 'ssm_w_glu': ssm_w_glu, 'diff_lambda': diff_lambda, 'diff_norm_g': diff_norm_g,
            'fox_f_bias': fox_f_bias, 'ln1_g': ln1_g, 'ln1_b': ln1_b,
            'moe_w_group': moe_w_group, 'moe_b_group': moe_b_group,
            'moe_w_expert': moe_w_expert, 'moe_b_expert': moe_b_expert,
            'moe_w_gate': moe_w_gate, 'moe_w_up': moe_w_up, 'moe_w_down': moe_w_down,
            'ln2_g': ln2_g, 'ln2_b': ln2_b}


def reference(x, w_in, w_branch, w_out, ssm_lambda_re, ssm_lambda_im, ssm_log_dt, ssm_b_re, ssm_b_im,
              ssm_c_re, ssm_c_im, ssm_d, ssm_w_glu, diff_lambda, diff_norm_g, fox_f_bias, ln1_g, ln1_b,
              moe_w_group, moe_b_group, moe_w_expert, moe_b_expert, moe_w_gate, moe_w_up, moe_w_down,
              ln2_g, ln2_b):
    s = x.shape[1]
    pos = jnp.arange(s, dtype=jnp.float32)
    inv_freq = ROPE_THETA ** (-jnp.arange(0, DIFF_HEAD_DIM, 2, dtype=jnp.float32) / DIFF_HEAD_DIM)
    ang = pos[:, None] * inv_freq[None, :]
    emb = jnp.concatenate([ang, ang], axis=-1)
    cos = jnp.cos(emb)
    sin = jnp.sin(emb)
    for l in range(DEPTH):
        lam_init = 0.8 - 0.6 * math.exp(-0.3 * l)
        mix = token_mixer(x, w_in[l], w_branch[l], w_out[l], ssm_lambda_re[l], ssm_lambda_im[l],
                          ssm_log_dt[l], ssm_b_re[l], ssm_b_im[l], ssm_c_re[l], ssm_c_im[l], ssm_d[l],
                          ssm_w_glu[l], diff_lambda[l], diff_norm_g[l], fox_f_bias[l], lam_init, cos, sin)
        x = layer_norm(ALPHA * x + mix, ln1_g[l], ln1_b[l])
        ff = hier_moe(x, moe_w_group[l], moe_b_group[l], moe_w_expert[l], moe_b_expert[l],
                      moe_w_gate[l], moe_w_up[l], moe_w_down[l])
        x = layer_norm(ALPHA * x + ff, ln2_g[l], ln2_b[l])
    return x
```

```cpp
#include <hip/hip_runtime.h>
#include <cstdio>
#include <cstdint>
#include <cstring>
namespace pg8 {
#define PG8_LAS __attribute__((address_space(3)))
typedef unsigned short bf16_t;
typedef short bf16x8 __attribute__((ext_vector_type(8)));
typedef float f32x4 __attribute__((ext_vector_type(4)));
typedef unsigned u32x4 __attribute__((ext_vector_type(4)));
constexpr int BM = 256, BK = 64, HALF = 128, HTB = HALF * BK * 2  , STAGE_BYTES = 8 * HTB, NXCD = 8, WGM = 8;

__host__ __device__ __forceinline__ int lds_byte(int r, int c) { const int st = (r >> 4) * 2 + (c >> 5), rr = r & 15, cc = c & 31, ob = rr * 64 + cc * 2; return st * 1024 + (ob ^ (((ob >> 9) & 1) << 5)); }
__host__ __device__ __forceinline__ void stage_rc(int b, int& R, int& C) { const int st = b / 1024, sb = b % 1024, swz = sb ^ (((sb >> 9) & 1) << 5); R = (st >> 1) * 16 + swz / 64; C = (st & 1) * 32 + (swz % 64) / 2; }
__host__ __device__ __forceinline__ int perm32(int rho) { const int n = rho >> 4, i = rho & 15; return 8 * (i >> 2) + 4 * n + (i & 3); }

struct Unit { int pm, pn, z; };
struct Gemm { const bf16_t* A; const bf16_t* Bt; long zA, zB; int M, N, K, lda, ldb, pad; };

struct StaticOrder {
    int nM, nN, nwg, G, c;
    __host__ __device__ void init(int M, int N, int G_, int c_) { nM = M / BM; nN = N / BM; nwg = nM * nN; G = G_; c = c_; }
    __host__ __device__ bool next(int i, Unit& u) const {
        const long L = (long)i * G + c; if (L >= nwg) return false;
        int wgid = (int)L; { const int q = nwg / NXCD, r = nwg % NXCD, xcd = wgid % NXCD, off = wgid / NXCD; wgid = (xcd < r ? xcd * (q + 1) : r * (q + 1) + (xcd - r) * q) + off; }
        const int nig = WGM * nN, gid = wgid / nig, fm = gid * WGM, gsz = (nM - fm) < WGM ? (nM - fm) : WGM;
        u.pm = fm + ((wgid % nig) % gsz); u.pn = (wgid % nig) / gsz; u.z = 0; return true;
    }
    __device__ __forceinline__ void a_ready(const Unit&) const {}
    __device__ __forceinline__ void done(const Unit&) const {}
};

typedef float f32x2_cv __attribute__((ext_vector_type(2))); typedef __bf16 bf16x2_cv __attribute__((ext_vector_type(2)));
__device__ __forceinline__ unsigned cvt_pk_bf16(float lo, float hi) { f32x2_cv v = {lo, hi}; bf16x2_cv b = __builtin_convertvector(v, bf16x2_cv); return __builtin_bit_cast(unsigned, b); }
typedef float f32x2 __attribute__((ext_vector_type(2)));

struct BatchOrder {
    StaticOrder T; int nz;
    __host__ __device__ void init(int M, int N, int nz_, int G_, int c_) { T.init(M, N, G_, c_); nz = nz_; }
    __host__ __device__ bool next(int i, Unit& u) const { const int j = i / nz; if (!T.next(j, u)) return false; u.z = i - j * nz; return true; }
    __device__ __forceinline__ void a_ready(const Unit&) const {}
    __device__ __forceinline__ void done(const Unit&) const {}
};
struct EpiStoreBf16 {
    static constexpr bool PERM = true, AFTER_DRAIN = false, CHAIN = false;
    bf16_t* O; int ldc, pad; long zO;
    __device__ __forceinline__ void operator()(const f32x4 (&acc)[2][2][4][2], const Unit& u, int wr, int wc, int fr, int fq) const {
        const int row0 = u.pm * BM + wr * 64 + fr, col0 = u.pn * BM + wc * 32 + 8 * fq;
#pragma unroll
        for (int ai = 0; ai < 2; ++ai)
#pragma unroll
            for (int m = 0; m < 4; ++m) { bf16_t* rowp = O + (size_t)u.z * zO + (size_t)(row0 + ai * HALF + m * 16) * ldc + col0;
#pragma unroll
                for (int bj = 0; bj < 2; ++bj) { const f32x4 v0 = acc[ai][bj][m][0], v1 = acc[ai][bj][m][1];
                    u32x4 w; w.x = cvt_pk_bf16(v0[0], v0[1]); w.y = cvt_pk_bf16(v0[2], v0[3]); w.z = cvt_pk_bf16(v1[0], v1[1]); w.w = cvt_pk_bf16(v1[2], v1[3]);
                    *(u32x4*)(rowp + bj * HALF) = w; } }
    }
};
struct EpiStoreF32 {
    static constexpr bool PERM = false, AFTER_DRAIN = false, CHAIN = false;
    float* C; int ldc, pad;
    __device__ __forceinline__ void operator()(const f32x4 (&acc)[2][2][4][2], const Unit& u, int wr, int wc, int fr, int fq) const {
        const int row0 = u.pm * BM + wr * 64 + fr, col0 = u.pn * BM + wc * 32 + 4 * fq;
#pragma unroll
        for (int ai = 0; ai < 2; ++ai)
#pragma unroll
            for (int m = 0; m < 4; ++m) { float* rowp = C + (size_t)(row0 + ai * HALF + m * 16) * ldc + col0;
#pragma unroll
                for (int bj = 0; bj < 2; ++bj)
#pragma unroll
                    for (int n = 0; n < 2; ++n) *(f32x4*)(rowp + bj * HALF + n * 16) = acc[ai][bj][m][n]; }
    }
};
__device__ __forceinline__ float sigm(float z) { return __builtin_amdgcn_rcpf(1.f + __builtin_amdgcn_exp2f(-1.4426950408889634f * z)); }
typedef unsigned u32x2 __attribute__((ext_vector_type(2)));
struct EpiInProj {
    static constexpr bool PERM = true, AFTER_DRAIN = false, CHAIN = false;
    bf16_t* PROJ; bf16_t* GL; const float* rope; float c2; int pad;
    __device__ __forceinline__ void operator()(const f32x4 (&acc)[2][2][4][2], const Unit& u, int wr, int wc, int fr, int fq) const {
        const int row0 = u.pm * BM + wr * 64 + fr, pn = u.pn;
        if (pn >= 14) {
            const int col0 = (pn - 14) * BM + wc * 32 + 8 * fq;
#pragma unroll
            for (int ai = 0; ai < 2; ++ai)
#pragma unroll
                for (int m = 0; m < 4; ++m) { bf16_t* rowp = GL + (size_t)(row0 + ai * HALF + m * 16) * 3072 + col0;
#pragma unroll
                    for (int bj = 0; bj < 2; ++bj) { const f32x4 v0 = acc[ai][bj][m][0], v1 = acc[ai][bj][m][1];
                        u32x4 w; w.x = cvt_pk_bf16(sigm(v0[0]), sigm(v0[1])); w.y = cvt_pk_bf16(sigm(v0[2]), sigm(v0[3])); w.z = cvt_pk_bf16(sigm(v1[0]), sigm(v1[1])); w.w = cvt_pk_bf16(sigm(v1[2]), sigm(v1[3]));
                        *(u32x4*)(rowp + bj * HALF) = w; } }
        } else if (pn >= 2 && pn < 6) {
            const float sc = pn < 4 ? c2 : 1.f; const int q4 = 4 * (4 * (wc & 1) + fq);
#pragma unroll
            for (int ai = 0; ai < 2; ++ai)
#pragma unroll
                for (int m = 0; m < 4; ++m) { const int row = row0 + ai * HALF + m * 16, s = row & 2047;
                    const f32x4 cs = *(const f32x4*)(rope + s * 32 + q4) * sc, sn = *(const f32x4*)(rope + 65536 + s * 32 + q4) * sc;
                    bf16_t* rowp = PROJ + (size_t)row * 3584 + pn * BM + 64 * (wc >> 1) + q4;
#pragma unroll
                    for (int bj = 0; bj < 2; ++bj) { const f32x4 t1 = acc[ai][bj][m][0], t2 = acc[ai][bj][m][1]; const f32x4 o1 = t1 * cs - t2 * sn, o2 = t2 * cs + t1 * sn;
                        u32x2 w1, w2; w1.x = cvt_pk_bf16(o1[0], o1[1]); w1.y = cvt_pk_bf16(o1[2], o1[3]); w2.x = cvt_pk_bf16(o2[0], o2[1]); w2.y = cvt_pk_bf16(o2[2], o2[3]);
                        *(u32x2*)(rowp + bj * HALF) = w1; *(u32x2*)(rowp + bj * HALF + 32) = w2; } }
        } else {
            const float sc = (pn == 8 || pn == 9) ? c2 : 1.f; const int col0 = pn * BM + wc * 32 + 8 * fq;
#pragma unroll
            for (int ai = 0; ai < 2; ++ai)
#pragma unroll
                for (int m = 0; m < 4; ++m) { bf16_t* rowp = PROJ + (size_t)(row0 + ai * HALF + m * 16) * 3584 + col0;
#pragma unroll
                    for (int bj = 0; bj < 2; ++bj) { const f32x4 v0 = acc[ai][bj][m][0] * sc, v1 = acc[ai][bj][m][1] * sc;
                        u32x4 w; w.x = cvt_pk_bf16(v0[0], v0[1]); w.y = cvt_pk_bf16(v0[2], v0[3]); w.z = cvt_pk_bf16(v1[0], v1[1]); w.w = cvt_pk_bf16(v1[2], v1[3]);
                        *(u32x4*)(rowp + bj * HALF) = w; } }
        }
    }
};
struct EpiGlu {
    static constexpr bool PERM = true, AFTER_DRAIN = false, CHAIN = false;
    bf16_t* YS; int ldc, pad;
    __device__ __forceinline__ void operator()(const f32x4 (&acc)[2][2][4][2], const Unit& u, int wr, int wc, int fr, int fq) const {
        const int row0 = u.pm * BM + wr * 64 + fr, col0 = u.pn * 128 + 16 * wc + 4 * fq;
#pragma unroll
        for (int ai = 0; ai < 2; ++ai)
#pragma unroll
            for (int m = 0; m < 4; ++m) { bf16_t* rowp = YS + (size_t)(row0 + ai * HALF + m * 16) * ldc + col0;
#pragma unroll
                for (int bj = 0; bj < 2; ++bj) { const f32x4 v = acc[ai][bj][m][0], g = acc[ai][bj][m][1];
                    u32x2 w; w.x = cvt_pk_bf16(v[0] * sigm(g[0]), v[1] * sigm(g[1])); w.y = cvt_pk_bf16(v[2] * sigm(g[2]), v[3] * sigm(g[3]));
                    *(u32x2*)(rowp + bj * 64) = w; } }
    }
};

struct MoeTables { const PG8_LAS int* tb; const PG8_LAS int* cnt; };
template <int NCT> struct MoeOrder {
    MoeTables T; const int* tokl; int G, c, lda2;
    __device__ __forceinline__ bool next(int i, Unit& u) const {
        const int L = i * G + c, rt = L / NCT; if (rt >= __builtin_amdgcn_readfirstlane(T.tb[16])) return false;
        const int e = __builtin_amdgcn_readfirstlane(T.tb[64 + rt]);
        u.pm = rt; u.pn = L - rt * NCT; u.z = e; return true;
    }
    __device__ __forceinline__ unsigned a_off(const Unit& u, int row) const {
        const int pos = (u.pm - __builtin_amdgcn_readfirstlane(T.tb[u.z])) * 256 + row; const int tok = tokl[u.z * 16384 + (pos < __builtin_amdgcn_readfirstlane(T.cnt[u.z]) ? pos : 0)];
        return (unsigned)tok * (unsigned)lda2;
    }
    __device__ __forceinline__ void a_ready(const Unit&) const {}
    __device__ __forceinline__ void done(const Unit&) const {}
};
template <int NCT> struct MoeTileOrder {
    MoeTables T; const int* tokl; int rt0, step, lda2;
    __device__ __forceinline__ bool next(int i, Unit& u) const {
        const int rt = rt0 + (i / NCT) * step; if (rt >= __builtin_amdgcn_readfirstlane(T.tb[16])) return false;
        u.pm = rt; u.pn = i % NCT; u.z = __builtin_amdgcn_readfirstlane(T.tb[64 + rt]); return true;
    }
    __device__ __forceinline__ unsigned a_off(const Unit& u, int row) const {
        const int pos = (u.pm - __builtin_amdgcn_readfirstlane(T.tb[u.z])) * 256 + row; const int tok = tokl[u.z * 16384 + (pos < __builtin_amdgcn_readfirstlane(T.cnt[u.z]) ? pos : 0)];
        return (unsigned)tok * (unsigned)lda2;
    }
    __device__ __forceinline__ void a_ready(const Unit&) const {}
    __device__ __forceinline__ void done(const Unit&) const {}
};
struct EpiMoeUp {
    static constexpr bool PERM = true, AFTER_DRAIN = false, CHAIN = false;
    bf16_t* H; const float* wl; MoeTables T;
    __device__ __forceinline__ void operator()(const f32x4 (&acc)[2][2][4][2], const Unit& u, int wr, int wc, int fr, int fq) const {
        const int r0 = wr * 64 + fr, col0 = u.pn * 128 + 16 * wc + 4 * fq, e = u.z, pos0 = (u.pm - __builtin_amdgcn_readfirstlane(T.tb[e])) * 256, n = __builtin_amdgcn_readfirstlane(T.cnt[e]);
#pragma unroll
        for (int ai = 0; ai < 2; ++ai)
#pragma unroll
            for (int m = 0; m < 4; ++m) { const int r = r0 + ai * HALF + m * 16, pos = pos0 + r; const float w = pos < n ? wl[e * 16384 + pos] : 0.f;
                bf16_t* rowp = H + (size_t)(u.pm * 256 + r) * 256 + col0;
#pragma unroll
                for (int bj = 0; bj < 2; ++bj) { const f32x4 gt = acc[ai][bj][m][0], up = acc[ai][bj][m][1];
                    u32x2 o; o.x = cvt_pk_bf16(gt[0] * sigm(gt[0]) * up[0] * w, gt[1] * sigm(gt[1]) * up[1] * w); o.y = cvt_pk_bf16(gt[2] * sigm(gt[2]) * up[2] * w, gt[3] * sigm(gt[3]) * up[3] * w);
                    *(u32x2*)(rowp + bj * 64) = o; } }
    }
};

struct EpiGatedChain {
    static constexpr bool PERM = true, AFTER_DRAIN = false, CHAIN = true;
    bf16_t* MG; const bf16_t* GL;
    __device__ __forceinline__ bool keep(const Unit& u) const { return u.z < 2; }
    __device__ __forceinline__ void chain(f32x4 (&acc)[2][2][4][2], const Unit& u, int wr, int wc, int fr, int fq) const {
        const int row0 = u.pm * BM + wr * 64 + fr, col0 = u.pn * BM + wc * 32 + 8 * fq, z = u.z; const float eps = 5.9604645e-08f;
#pragma unroll
        for (int ai = 0; ai < 2; ++ai)
#pragma unroll
            for (int m = 0; m < 4; ++m) { const size_t row = (size_t)(row0 + ai * HALF + m * 16); const bf16_t* gp = GL + row * 3072 + z * 1024 + col0;
#pragma unroll
                for (int bj = 0; bj < 2; ++bj) { const u32x4 ga = *(const u32x4*)(gp + bj * HALF); float f[8];
                    f[0] = __builtin_bit_cast(float, ga.x << 16); f[1] = __builtin_bit_cast(float, ga.x & 0xffff0000u); f[2] = __builtin_bit_cast(float, ga.y << 16); f[3] = __builtin_bit_cast(float, ga.y & 0xffff0000u);
                    f[4] = __builtin_bit_cast(float, ga.z << 16); f[5] = __builtin_bit_cast(float, ga.z & 0xffff0000u); f[6] = __builtin_bit_cast(float, ga.w << 16); f[7] = __builtin_bit_cast(float, ga.w & 0xffff0000u);
#pragma unroll
                    for (int e = 0; e < 8; ++e) f[e] = fmaxf(f[e], eps);
                    if (z < 2) { const u32x4 gb = *(const u32x4*)(gp + 1024 + bj * HALF); float d[8];
                        d[0] = __builtin_bit_cast(float, gb.x << 16); d[1] = __builtin_bit_cast(float, gb.x & 0xffff0000u); d[2] = __builtin_bit_cast(float, gb.y << 16); d[3] = __builtin_bit_cast(float, gb.y & 0xffff0000u);
                        d[4] = __builtin_bit_cast(float, gb.z << 16); d[5] = __builtin_bit_cast(float, gb.z & 0xffff0000u); d[6] = __builtin_bit_cast(float, gb.w << 16); d[7] = __builtin_bit_cast(float, gb.w & 0xffff0000u);
#pragma unroll
                        for (int e = 0; e < 8; ++e) f[e] = f[e] * __builtin_amdgcn_rcpf(fmaxf(d[e], eps)); }
                    f32x4& v0 = acc[ai][bj][m][0]; f32x4& v1 = acc[ai][bj][m][1];
                    v0[0] *= f[0]; v0[1] *= f[1]; v0[2] *= f[2]; v0[3] *= f[3]; v1[0] *= f[4]; v1[1] *= f[5]; v1[2] *= f[6]; v1[3] *= f[7];
                    if (z == 2) { u32x4 w; w.x = cvt_pk_bf16(v0[0], v0[1]); w.y = cvt_pk_bf16(v0[2], v0[3]); w.z = cvt_pk_bf16(v1[0], v1[1]); w.w = cvt_pk_bf16(v1[2], v1[3]);
                        *(u32x4*)(MG + row * 1024 + col0 + bj * HALF) = w; } }
                if (m & 1) asm volatile("" ::: "memory"); }
    }
};
template <class Epi, class Sched, bool ALIGN_EPI = false, bool SP2 = false, bool GATHER = false>
__device__ __forceinline__ void gemm_phase(PG8_LAS unsigned char* lds, const Gemm g, const Sched& S, const Epi& E) {
    int tid_ = threadIdx.x; asm volatile("" : "+v"(tid_));
    const int tid = tid_, wid = __builtin_amdgcn_readfirstlane(tid >> 6), lane = tid & 63, wr = wid >> 2, wc = wid & 3, fr = lane & 15, fq = lane >> 4;
    const int K = g.K, nt = K / BK;
    unsigned voffA[2], voffB[2]; int rowA[2], colA2[2];
#pragma unroll
    for (int i = 0; i < 2; ++i) { int R, C; stage_rc(tid * 16 + i * 8192, R, C); const int Rb = Epi::PERM ? ((R & ~31) + perm32(R & 31)) : R;
        voffA[i] = (unsigned)(R * g.lda + C) * 2u; voffB[i] = (unsigned)(Rb * g.ldb + C) * 2u; rowA[i] = R; colA2[i] = C * 2; }
    unsigned gC[2][2], gN[2][2], g2[2][2];
#define PG8_VAC(h) (GATHER ? gC[h] : voffA)
#define PG8_VA2(h) (GATHER ? g2[h] : voffA)
#define PG8_GOFF(dst, u) do { if constexpr (GATHER) { _Pragma("unroll") for (int h_ = 0; h_ < 2; ++h_) _Pragma("unroll") for (int i_ = 0; i_ < 2; ++i_) dst[h_][i_] = S.a_off(u, 128 * h_ + rowA[i_]) + (unsigned)colA2[i_]; } } while (0)
    const size_t kstep = (size_t)(BK * 2);
    const size_t hstepA = GATHER ? (size_t)0 : (size_t)HALF * g.lda * 2, hstepB = (size_t)HALF * g.ldb * 2;
    const size_t tstepA = 2 * hstepA, tstepB = 2 * hstepB;
    const unsigned ldsw = (unsigned)wid * 1024u;
    const int aoff = lds_byte(wr * 64 + fr, fq * 8), boff = lds_byte(wc * 32 + fr, fq * 8);
#define PG8_SA(b, h) (((b) * 2 + (h)) * HTB)
#define PG8_SB(b, h) ((4 + (b) * 2 + (h)) * HTB)
#define PG8_STAGE(bufoff, gbase, voff) do { _Pragma("unroll") for (int _i = 0; _i < 2; ++_i) \
        __builtin_amdgcn_global_load_lds((const unsigned*)((const char*)(gbase) + (voff)[_i]), (PG8_LAS unsigned*)(lds + (bufoff) + ldsw + _i * 8192), 16, 0, 0); } while (0)
#define PG8_LDA(dst, b, h) do { _Pragma("unroll") for (int m = 0; m < 4; ++m) _Pragma("unroll") for (int k = 0; k < 2; ++k) dst[m][k] = *(const PG8_LAS bf16x8*)(lds + PG8_SA(b, h) + aoff + m * 2048 + k * 1024); } while (0)
#define PG8_LDB(dst, b, h) do { _Pragma("unroll") for (int n = 0; n < 2; ++n) _Pragma("unroll") for (int k = 0; k < 2; ++k) dst[n][k] = *(const PG8_LAS bf16x8*)(lds + PG8_SB(b, h) + boff + n * 2048 + k * 1024); } while (0)
#define PG8_MMA(ai, bj, At, Bt) do { __builtin_amdgcn_s_setprio(1); _Pragma("unroll") for (int m = 0; m < 4; ++m) _Pragma("unroll") for (int n = 0; n < 2; ++n) _Pragma("unroll") for (int k = 0; k < 2; ++k) \
        acc[ai][bj][m][n] = __builtin_amdgcn_mfma_f32_16x16x32_bf16(Bt[n][k], At[m][k], acc[ai][bj][m][n], 0, 0, 0); __builtin_amdgcn_s_setprio(0); } while (0)
#define PG8_WAIT_V(n) asm volatile("s_waitcnt vmcnt(" #n ")" ::: "memory")
#define PG8_WAIT_L(n) asm volatile("s_waitcnt lgkmcnt(" #n ")" ::: "memory")
#define PG8_BAR __builtin_amdgcn_s_barrier()
#define PG8_SCHED __builtin_amdgcn_sched_barrier(0)
    Unit cur, nxt; int ui = 0;
    if (!S.next(0, cur)) return;
    f32x4 acc[2][2][4][2];
    { float z_ = 0.f; asm volatile("" : "+v"(z_));
#pragma unroll
    for (int a = 0; a < 2; ++a)
#pragma unroll
        for (int b = 0; b < 2; ++b)
#pragma unroll
            for (int m = 0; m < 4; ++m)
#pragma unroll
                for (int n = 0; n < 2; ++n) acc[a][b][m][n] = (f32x4){z_, z_, z_, z_}; }
    bf16x8 At[4][2], B0[2][2], B1[2][2];
    const char* cA = (const char*)g.A + (GATHER ? (size_t)0 : (size_t)cur.pm * tstepA) + (size_t)cur.z * g.zA; const char* cB = (const char*)g.Bt + (size_t)cur.pn * tstepB + (size_t)cur.z * g.zB;
    S.a_ready(cur);
    PG8_GOFF(gC, cur);
    if constexpr (SP2) {
        PG8_STAGE(PG8_SB(0, 0), cB, voffB); PG8_STAGE(PG8_SB(0, 1), cB + hstepB, voffB); PG8_STAGE(PG8_SA(0, 0), cA, PG8_VAC(0)); PG8_STAGE(PG8_SA(0, 1), cA + hstepA, PG8_VAC(1));
        if (wr == 1) PG8_BAR;
        PG8_WAIT_V(2); PG8_BAR;
        PG8_STAGE(PG8_SB(1, 0), cB + kstep, voffB); PG8_STAGE(PG8_SA(1, 0), cA + kstep, PG8_VAC(0)); PG8_STAGE(PG8_SB(1, 1), cB + hstepB + kstep, voffB);
        PG8_WAIT_V(6); PG8_BAR;
    } else {
        PG8_STAGE(PG8_SB(0, 0), cB, voffB); PG8_STAGE(PG8_SA(0, 0), cA, PG8_VAC(0)); PG8_STAGE(PG8_SB(0, 1), cB + hstepB, voffB); PG8_STAGE(PG8_SA(0, 1), cA + hstepA, PG8_VAC(1));
        if (wr == 1) PG8_BAR;
        PG8_WAIT_V(4); PG8_BAR;
        PG8_STAGE(PG8_SB(1, 0), cB + kstep, voffB); PG8_STAGE(PG8_SA(1, 0), cA + kstep, PG8_VAC(0)); PG8_STAGE(PG8_SB(1, 1), cB + hstepB + kstep, voffB);
        PG8_WAIT_V(6); PG8_BAR;
    }
    for (;;) {
        const bool has_next = S.next(ui + 1, nxt);
        if constexpr (GATHER) { if (has_next) PG8_GOFF(gN, nxt); else { _Pragma("unroll") for (int h_ = 0; h_ < 2; ++h_) _Pragma("unroll") for (int i_ = 0; i_ < 2; ++i_) gN[h_][i_] = gC[h_][i_]; } }
        const char* nA = has_next ? (const char*)g.A + (GATHER ? (size_t)0 : (size_t)nxt.pm * tstepA) + (size_t)nxt.z * g.zA : cA; const char* nB = has_next ? (const char*)g.Bt + (size_t)nxt.pn * tstepB + (size_t)nxt.z * g.zB : cB;
#pragma unroll 1
        for (int t = 0; t < nt; t += 2) {
            const bool last = (t == nt - 2);
            if constexpr (GATHER) { _Pragma("unroll") for (int h_ = 0; h_ < 2; ++h_) _Pragma("unroll") for (int i_ = 0; i_ < 2; ++i_) g2[h_][i_] = last ? gN[h_][i_] : gC[h_][i_]; }
            const char* a1 = cA + (size_t)(t + 1) * kstep;
            const char* a2 = last ? nA : cA + (size_t)(t + 2) * kstep; const char* b2 = last ? nB : cB + (size_t)(t + 2) * kstep;
            const char* a3 = a2 + kstep; const char* b3 = b2 + kstep;
            if (last && has_next) S.a_ready(nxt);
            if constexpr (SP2) {
            PG8_LDB(B0, 0, 0); PG8_LDB(B1, 0, 1); PG8_SCHED; PG8_LDA(At, 0, 0); PG8_STAGE(PG8_SA(1, 1), a1 + hstepA, PG8_VAC(1));
            PG8_WAIT_V(8); PG8_WAIT_L(0); PG8_BAR; PG8_MMA(0, 0, At, B0); PG8_MMA(0, 1, At, B1); PG8_BAR; PG8_SCHED;
            PG8_LDA(At, 0, 1); PG8_STAGE(PG8_SB(0, 0), b2, voffB); PG8_STAGE(PG8_SB(0, 1), b2 + hstepB, voffB); PG8_STAGE(PG8_SA(0, 0), a2, PG8_VA2(0));
            PG8_WAIT_V(8); PG8_WAIT_L(0); PG8_BAR; PG8_MMA(1, 0, At, B0); PG8_MMA(1, 1, At, B1); PG8_BAR; PG8_SCHED;
            PG8_LDB(B0, 1, 0); PG8_LDB(B1, 1, 1); PG8_SCHED; PG8_LDA(At, 1, 0); PG8_STAGE(PG8_SA(0, 1), a2 + hstepA, PG8_VA2(1));
            PG8_WAIT_V(8); PG8_WAIT_L(0); PG8_BAR; PG8_MMA(0, 0, At, B0); PG8_MMA(0, 1, At, B1); PG8_BAR; PG8_SCHED;
            PG8_LDA(At, 1, 1); PG8_STAGE(PG8_SB(1, 0), b3, voffB); PG8_STAGE(PG8_SB(1, 1), b3 + hstepB, voffB); PG8_STAGE(PG8_SA(1, 0), a3, PG8_VA2(0));
            PG8_WAIT_V(8); PG8_WAIT_L(0); PG8_BAR; PG8_MMA(1, 0, At, B0); PG8_MMA(1, 1, At, B1); PG8_BAR; PG8_SCHED;
            } else {
            PG8_LDB(B0, 0, 0); PG8_SCHED; PG8_LDA(At, 0, 0); PG8_STAGE(PG8_SA(1, 1), a1 + hstepA, PG8_VAC(1));
            PG8_WAIT_L(8); PG8_BAR; PG8_WAIT_L(0); PG8_MMA(0, 0, At, B0); PG8_BAR; PG8_SCHED;
            PG8_LDB(B1, 0, 1); PG8_STAGE(PG8_SB(0, 0), b2, voffB);
            PG8_BAR; PG8_WAIT_L(0); PG8_MMA(0, 1, At, B1); PG8_BAR;
            PG8_LDA(At, 0, 1); PG8_STAGE(PG8_SA(0, 0), a2, PG8_VA2(0));
            PG8_BAR; PG8_WAIT_L(0); PG8_MMA(1, 0, At, B0); PG8_BAR; PG8_SCHED;
            PG8_STAGE(PG8_SB(0, 1), b2 + hstepB, voffB);
            PG8_WAIT_V(6); PG8_BAR; PG8_MMA(1, 1, At, B1); PG8_BAR;
            PG8_LDB(B0, 1, 0); PG8_SCHED; PG8_LDA(At, 1, 0); PG8_STAGE(PG8_SA(0, 1), a2 + hstepA, PG8_VA2(1));
            PG8_WAIT_L(8); PG8_BAR; PG8_WAIT_L(0); PG8_MMA(0, 0, At, B0); PG8_BAR; PG8_SCHED;
            PG8_LDB(B1, 1, 1); PG8_STAGE(PG8_SB(1, 0), b3, voffB);
            PG8_BAR; PG8_WAIT_L(0); PG8_MMA(0, 1, At, B1); PG8_BAR;
            PG8_LDA(At, 1, 1); PG8_STAGE(PG8_SA(1, 0), a3, PG8_VA2(0));
            PG8_BAR; PG8_WAIT_L(0); PG8_MMA(1, 0, At, B0); PG8_BAR; PG8_SCHED;
            PG8_STAGE(PG8_SB(1, 1), b3 + hstepB, voffB);
            PG8_WAIT_V(6); PG8_BAR; PG8_MMA(1, 1, At, B1); PG8_BAR;
            }
        }
        if constexpr (ALIGN_EPI) { if (wr == 0) PG8_BAR; }
        if constexpr (Epi::CHAIN) { E.chain(acc, cur, wr, wc, fr, fq); S.done(cur); }
        else if constexpr (!Epi::AFTER_DRAIN) { E(acc, cur, wr, wc, fr, fq); S.done(cur); }
        if (!has_next) break;
        bool keep_ = false; if constexpr (Epi::CHAIN) keep_ = E.keep(cur);
        if (!keep_) { float z_ = 0.f; asm volatile("" : "+v"(z_));
#pragma unroll
        for (int a = 0; a < 2; ++a)
#pragma unroll
            for (int b = 0; b < 2; ++b)
#pragma unroll
                for (int m = 0; m < 4; ++m)
#pragma unroll
                    for (int n = 0; n < 2; ++n) acc[a][b][m][n] = (f32x4){z_, z_, z_, z_}; }
        cur = nxt; cA = nA; cB = nB; ++ui;
        if constexpr (GATHER) { _Pragma("unroll") for (int h_ = 0; h_ < 2; ++h_) _Pragma("unroll") for (int i_ = 0; i_ < 2; ++i_) gC[h_][i_] = gN[h_][i_]; }
        if constexpr (ALIGN_EPI) { if (wr == 1) PG8_BAR; }
    }
    PG8_WAIT_V(0);
    if constexpr (!ALIGN_EPI) { if (wr == 0) PG8_BAR; }
    PG8_BAR;
    if constexpr (Epi::AFTER_DRAIN) { E.fused(acc, cur, wr, wc, fr, fq, lds, wid, lane); S.done(cur); }
#undef PG8_SA
#undef PG8_VAC
#undef PG8_VA2
#undef PG8_GOFF
#undef PG8_SB
#undef PG8_STAGE
#undef PG8_LDA
#undef PG8_LDB
#undef PG8_MMA
#undef PG8_WAIT_V
#undef PG8_WAIT_L
#undef PG8_BAR
#undef PG8_SCHED
}
}
#include <hip/hip_bf16.h>
#include <cmath>
namespace attn_body {
using bf16=__hip_bfloat16;
using bf16x8=__attribute__((ext_vector_type(8)))short;
using s16x4=__attribute__((ext_vector_type(4)))short;
using f32x16=__attribute__((ext_vector_type(16)))float;
using u32x4=__attribute__((ext_vector_type(4)))unsigned;
constexpr int BATCH=8,SEQ=2048,D=64,DM=3584;
constexpr int NW=8,QBLK=32,QB=QBLK*NW,KVBLK=64,NQB=SEQ/QB;
constexpr int ATTN_PITCH=DM, ATTN_UNIT_ROWS=QB;
__device__ __forceinline__ int crow(int r,int hi){return (r&3)+8*(r>>2)+4*hi;}
#define SBAR() __builtin_amdgcn_sched_barrier(0)
__device__ __forceinline__ void cmask(f32x16&p0,f32x16&p1,int jb,int qrel,int hi){
  const float NEG=-INFINITY; int kb=64*jb+4*hi;
  #pragma unroll
  for(int r=0;r<16;++r){int kv=kb+(r&3)+8*(r>>2); if(kv>qrel)p0[r]=NEG; if(kv+32>qrel)p1[r]=NEG;}
}

constexpr int NSLOT=3, SLOTB=8192;
constexpr int LDS_K=0, LDS_V=NSLOT*SLOTB, LDS_WS=2*NSLOT*SLOTB, LDS_OST=LDS_WS+NW*64*4, LDS_BIAS=LDS_OST+NW*4096, LDS_BYTES=LDS_BIAS+SEQ*4;
constexpr float C2=0.125f*1.4426950408889634f;
__device__ __forceinline__ void glds16(const void*gsrc,unsigned lds_dst){unsigned keep;
  asm volatile("s_mov_b32 %0, m0\n\ts_mov_b32 m0, %2\n\ts_nop 0\n\tglobal_load_lds_dwordx4 %1, off\n\ts_mov_b32 m0, %0":"=&s"(keep):"v"(gsrc),"s"(lds_dst):"memory");}
__device__ __forceinline__ float max3f(float a,float b,float c){float r;asm("v_max3_f32 %0, %1, %2, %3":"=v"(r):"v"(a),"v"(b),"v"(c));return r;}
__device__ __forceinline__ float max2f(float a,float b){float r;asm("v_max_f32_e32 %0, %1, %2":"=v"(r):"v"(a),"v"(b));return r;}
__device__ __forceinline__ float fadd_s(float a,float b){float r;asm("v_add_f32_e32 %0, %1, %2":"=v"(r):"v"(a),"v"(b));return r;}
__device__ __forceinline__ float fsub_s(float a,float b){float r;asm("v_sub_f32_e32 %0, %1, %2":"=v"(r):"v"(a),"v"(b));return r;}
typedef float f32x2_t __attribute__((ext_vector_type(2))); typedef __bf16 bf16x2_t __attribute__((ext_vector_type(2)));
__device__ __forceinline__ unsigned cvtpk_s(float lo,float hi){f32x2_t v={lo,hi};bf16x2_t b=__builtin_convertvector(v,bf16x2_t);return __builtin_bit_cast(unsigned,b);}
#define WAIT_BAR(N) asm volatile("s_waitcnt vmcnt(" #N ") lgkmcnt(0)\n\ts_barrier":::"memory")

__device__ __forceinline__ void qkt(f32x16&p0,f32x16&p1,const char*Kslot,const bf16x8*qr,const f32x16&cin0,const f32x16&cin1,int r32,int hi){
  const char*kb=Kslot+hi*1024+r32*16;
  #pragma unroll
  for(int d0=0;d0<4;++d0){
    const bf16x8 b0=*reinterpret_cast<const bf16x8*>(kb+d0*2048);
    const bf16x8 b1=*reinterpret_cast<const bf16x8*>(kb+d0*2048+512);
    if(d0==0){p0=__builtin_amdgcn_mfma_f32_32x32x16_bf16(b0,qr[0],cin0,0,0,0);p1=__builtin_amdgcn_mfma_f32_32x32x16_bf16(b1,qr[0],cin1,0,0,0);}
    else{p0=__builtin_amdgcn_mfma_f32_32x32x16_bf16(b0,qr[d0],p0,0,0,0);p1=__builtin_amdgcn_mfma_f32_32x32x16_bf16(b1,qr[d0],p1,0,0,0);}}
}
typedef __attribute__((address_space(3))) const char* lds_cptr;
typedef short v4i16_t __attribute__((ext_vector_type(4)));
__device__ __forceinline__ void kload8(bf16x8*kf,lds_cptr kp){
  kf[0]=*(const __attribute__((address_space(3))) bf16x8*)(kp);      kf[1]=*(const __attribute__((address_space(3))) bf16x8*)(kp+512);
  kf[2]=*(const __attribute__((address_space(3))) bf16x8*)(kp+2048); kf[3]=*(const __attribute__((address_space(3))) bf16x8*)(kp+2560);
  kf[4]=*(const __attribute__((address_space(3))) bf16x8*)(kp+4096); kf[5]=*(const __attribute__((address_space(3))) bf16x8*)(kp+4608);
  kf[6]=*(const __attribute__((address_space(3))) bf16x8*)(kp+6144); kf[7]=*(const __attribute__((address_space(3))) bf16x8*)(kp+6656);
}
__device__ __forceinline__ void kload2(bf16x8*kf,lds_cptr kp,int j){ kf[2*j]=*(const __attribute__((address_space(3))) bf16x8*)(kp+j*2048); kf[2*j+1]=*(const __attribute__((address_space(3))) bf16x8*)(kp+j*2048+512); }
__device__ __forceinline__ s16x4 vtr(lds_cptr p){ return __builtin_bit_cast(s16x4,__builtin_amdgcn_ds_read_tr16_b64_v4i16((__attribute__((address_space(3))) v4i16_t*)p)); }
__device__ __forceinline__ float rowmax(const f32x16&p0,const f32x16&p1){
  float a=max3f(p0[0],p0[1],p1[0]),b=max3f(p0[2],p0[3],p1[1]);a=max3f(a,p1[2],p1[3]);
  #pragma unroll
  for(int r=4;r<16;r+=4){a=max3f(a,p0[r],p0[r+1]);b=max3f(b,p0[r+2],p0[r+3]);a=max3f(a,p1[r],p1[r+1]);b=max3f(b,p1[r+2],p1[r+3]);}
  const float m=max2f(a,b);
  auto rr=__builtin_amdgcn_permlane32_swap(__float_as_uint(m),__float_as_uint(m),false,false);
  return max2f(__uint_as_float(rr[0]),__uint_as_float(rr[1]));
}
__device__ __forceinline__ void pv(f32x16*o,int vb,bf16x8 pa0,bf16x8 pa1,bf16x8 pa2,bf16x8 pa3){
  #pragma unroll
  for(int d0=0;d0<2;++d0){s16x4 lo[4],hi[4];
    #pragma unroll
    for(int ks=0;ks<4;++ks){
      asm volatile("ds_read_b64_tr_b16 %0,%1 offset:%c2":"=&v"(lo[ks]):"v"(vb),"i"(d0*4096+ks*1024):"memory");
      asm volatile("ds_read_b64_tr_b16 %0,%1 offset:%c2":"=&v"(hi[ks]):"v"(vb),"i"(d0*4096+ks*1024+512):"memory");}
    asm volatile("s_waitcnt lgkmcnt(0)":::"memory");SBAR();
    #define PK(k) (bf16x8){lo[k][0],lo[k][1],lo[k][2],lo[k][3],hi[k][0],hi[k][1],hi[k][2],hi[k][3]}
    o[d0]=__builtin_amdgcn_mfma_f32_32x32x16_bf16(pa0,PK(0),o[d0],0,0,0);
    o[d0]=__builtin_amdgcn_mfma_f32_32x32x16_bf16(pa1,PK(1),o[d0],0,0,0);
    o[d0]=__builtin_amdgcn_mfma_f32_32x32x16_bf16(pa2,PK(2),o[d0],0,0,0);
    o[d0]=__builtin_amdgcn_mfma_f32_32x32x16_bf16(pa3,PK(3),o[d0],0,0,0);
    #undef PK
  }
}

#ifndef ATTN_STORE16
#define ATTN_STORE16(p,v) (*(u32x4*)(p)=(v))
#endif
template<int THRL,bool BIAS,int op> __device__ __forceinline__ void attn_unit(int b,int qb,const bf16*Qh,const bf16*__restrict__ Kh_,const bf16*__restrict__ Vh_,bf16*Oh,char*shm){
  int tid_=threadIdx.x; asm volatile("":"+v"(tid_));
  const int tid=tid_,lane=tid&63,r32=lane&31,hi=lane>>5; const int wid=__builtin_amdgcn_readfirstlane(tid>>6);
  const long rowbase=(long)b*SEQ; const int q0=qb*QB;
  const bf16*Qw=Qh+(rowbase+q0+wid*QBLK)*DM;
  const bf16*Kh=Kh_+rowbase*DM,*Vh=Vh_+rowbase*DM;
  typedef float f32x4_t __attribute__((ext_vector_type(4)));
  const __attribute__((address_space(3))) float* cb3=(const __attribute__((address_space(3))) float*)((__attribute__((address_space(3))) const char*)shm+LDS_BIAS)+4*hi;
  const unsigned lds0=(unsigned)(uintptr_t)shm;
  float*wsf=(float*)(shm+LDS_WS)+wid*64;
  const bf16*ksrc=Kh+(long)lane*DM+wid*8;
  const bf16*vsrc=Vh+(long)(16*(wid&3)+(lane>>2))*DM+(wid>>2)*32+(lane&3)*8;
  const unsigned kdst=lds0+LDS_K+wid*1024, vdst=lds0+LDS_V+wid*1024;
  #define DMA_K(t,slot) glds16(ksrc+(long)(t)*KVBLK*DM,(unsigned)__builtin_amdgcn_readfirstlane(kdst+(slot)))
  #define DMA_V(t,slot) glds16(vsrc+(long)(t)*KVBLK*DM,(unsigned)__builtin_amdgcn_readfirstlane(vdst+(slot)))
  const int vb0=(int)(lds0+LDS_V)+((lane>>4)&1)*32+(lane&3)*8+(4*hi+((lane&15)>>2))*64;
  const char*Kbase=shm+LDS_K; bf16x8 kf[8];
  const lds_cptr shm3=(lds_cptr)shm; const lds_cptr kp0=shm3+LDS_K+hi*1024+r32*16; const lds_cptr vp0=shm3+LDS_V+((lane>>4)&1)*32+(lane&3)*8+(4*hi+((lane&15)>>2))*64;
  const int NT=(q0+QB)/KVBLK;
  DMA_K(0,0);DMA_V(0,0);DMA_K(1,SLOTB);
  bf16x8 qr[4];
  #pragma unroll
  for(int d0=0;d0<4;++d0)qr[d0]=*reinterpret_cast<const bf16x8*>(&Qw[(long)r32*DM+d0*16+hi*8]);
  float mhat=0.f,l_reg=0.f;f32x16 o[2];float z_=0.f;asm volatile("":"+v"(z_));
  _Pragma("unroll") for(int r=0;r<16;++r){o[0][r]=z_;o[1][r]=z_;} f32x16 negm; _Pragma("unroll") for(int r=0;r<16;++r)negm[r]=z_; asm volatile("":"+v"(negm));
  const int qrel=wid*QBLK+r32;
  #define CMASK(P0,P1,t) do{int jb_=(t)-(NT-4); if(jb_>=0)cmask(P0,P1,jb_,qrel,hi);}while(0)
  bool resc=false;
  #define START(P0,P1) do{ const float rm=rowmax(P0,P1); resc=false; \
    { const float dl=rm; mhat=fadd_s(mhat,dl); \
      _Pragma("unroll") for(int r=0;r<16;++r){P0[r]=fsub_s(P0[r],dl);P1[r]=fsub_s(P1[r],dl);} \
      _Pragma("unroll") for(int r=0;r<16;++r)negm[r]=-mhat; asm volatile("":"+v"(negm)); } \
    _Pragma("unroll") for(int r=0;r<16;++r)P0[r]=__builtin_amdgcn_exp2f(P0[r]); }while(0)
  #define RESC() do{ if(resc){ asm volatile("s_waitcnt lgkmcnt(0)":::"memory"); \
      _Pragma("unroll") for(int d_=0;d_<2;++d_) _Pragma("unroll") for(int r=0;r<16;++r)o[d_][r]*=wsf[crow(r,hi)]; } }while(0)
  f32x16 pA0,pA1,pB0,pB1;
  #define LDBIAS(C0,C1,t) do{ if(BIAS){ _Pragma("unroll") for(int g_=0;g_<4;++g_){ const f32x4_t b0_=*(const __attribute__((address_space(3))) f32x4_t*)(cb3+64*(t)+8*g_), b1_=*(const __attribute__((address_space(3))) f32x4_t*)(cb3+64*(t)+32+8*g_); \
      C0[4*g_]=b0_[0]+negm[4*g_];C0[4*g_+1]=b0_[1]+negm[4*g_+1];C0[4*g_+2]=b0_[2]+negm[4*g_+2];C0[4*g_+3]=b0_[3]+negm[4*g_+3]; C1[4*g_]=b1_[0]+negm[4*g_];C1[4*g_+1]=b1_[1]+negm[4*g_+1];C1[4*g_+2]=b1_[2]+negm[4*g_+2];C1[4*g_+3]=b1_[3]+negm[4*g_+3]; } } }while(0)
  int sl_prev=0,sl_cur=0,sl_next=SLOTB;
  #define ROT() do{sl_prev=sl_cur;sl_cur=sl_next;sl_next=(sl_next==(NSLOT-1)*SLOTB)?0:sl_next+SLOTB;}while(0)
  DMA_K(2,2*SLOTB);
  WAIT_BAR(3);
  if(BIAS){ LDBIAS(pA0,pA1,0); qkt(pA0,pA1,Kbase,qr,pA0,pA1,r32,hi); } else qkt(pA0,pA1,Kbase,qr,negm,negm,r32,hi);
  asm volatile("s_nop 15\n\ts_nop 7":"+v"(pA0),"+v"(pA1));CMASK(pA0,pA1,0);
  START(pA0,pA1);
  _Pragma("unroll") for(int r=0;r<16;++r)pA1[r]=__builtin_amdgcn_exp2f(pA1[r]);
  WAIT_BAR(0);
  DMA_K(3,0);DMA_V(1,SLOTB);
  ROT();
  kload8(kf,kp0+sl_cur);
  WAIT_BAR(2);
  s16x4 vlo[8],vhi[8]; u32x4 pw0,pw1,pw2,pw3;
  #define PKW(P,B) cvtpk_s(P[B],P[B+1])
  #define PAF(k) __builtin_bit_cast(bf16x8,pw##k)
  #define VFR(i) (bf16x8){vlo[i][0],vlo[i][1],vlo[i][2],vlo[i][3],vhi[i][0],vhi[i][1],vhi[i][2],vhi[i][3]}
  #define PIN(x) asm volatile("":"+v"(x))
  #define MX3(a,b,c) __builtin_fmaxf(__builtin_fmaxf((a),(b)),(c))
  #define GAPA(MF,A0,A1,A2,A3,W0,W1,PW) do{ MF; sacc+=A0; sacc+=A1; sacc+=A2; sacc+=A3; PIN(sacc); W0; W1; PIN(PW); SBAR(); }while(0)
  #define EX(v) __builtin_amdgcn_exp2f(v)
  #define GAPB(MF,X,B) do{ MF; X[B]=EX(X[B]); X[B+1]=EX(X[B+1]); X[B+2]=EX(X[B+2]); X[B+3]=EX(X[B+3]); PIN(X); SBAR(); }while(0)
  #define VRD(i) do{ vlo[i]=vtr(vp_+(((i)>>2)*4096+((i)&3)*1024)); vhi[i]=vtr(vp_+(((i)>>2)*4096+((i)&3)*1024+512)); }while(0)
  #define KRD(G,j) do{ if(G){ kload2(kf,kp0+sl_next,j); SBAR(); } }while(0)
  #define STEP(C0,C1,P0,P1,t,GK,GV,GL) do{ SBAR(); \
    LDBIAS(C0,C1,t); SBAR(); \
    const lds_cptr vp_=vp0+sl_prev; \
    VRD(0); SBAR(); float sacc=(P0[0]+P0[1]); \
    GAPA(C0=__builtin_amdgcn_mfma_f32_32x32x16_bf16(kf[0],qr[0],(BIAS?C0:negm),0,0,0), P0[2],P0[3],P0[4],P0[5],     pw0[0]=PKW(P0,0), pw0[1]=PKW(P0,2), pw0); \
    VRD(4); SBAR(); GAPA(C1=__builtin_amdgcn_mfma_f32_32x32x16_bf16(kf[1],qr[0],(BIAS?C1:negm),0,0,0), P0[6],P0[7],P0[8],P0[9],     pw0[2]=PKW(P0,4), pw0[3]=PKW(P0,6), pw0); \
    VRD(1); SBAR(); GAPA(C0=__builtin_amdgcn_mfma_f32_32x32x16_bf16(kf[2],qr[1],C0,0,0,0),   P0[10],P0[11],P0[12],P0[13], pw1[0]=PKW(P0,8), pw1[1]=PKW(P0,10), pw1); \
    VRD(5); SBAR(); GAPA(C1=__builtin_amdgcn_mfma_f32_32x32x16_bf16(kf[3],qr[1],C1,0,0,0),   P0[14],P0[15],P1[0],P1[1],   pw1[2]=PKW(P0,12),pw1[3]=PKW(P0,14), pw1); \
    VRD(2); SBAR(); GAPA(C0=__builtin_amdgcn_mfma_f32_32x32x16_bf16(kf[4],qr[2],C0,0,0,0),   P1[2],P1[3],P1[4],P1[5],     pw2[0]=PKW(P1,0), pw2[1]=PKW(P1,2), pw2); \
    VRD(6); SBAR(); GAPA(C1=__builtin_amdgcn_mfma_f32_32x32x16_bf16(kf[5],qr[2],C1,0,0,0),   P1[6],P1[7],P1[8],P1[9],     pw2[2]=PKW(P1,4), pw2[3]=PKW(P1,6), pw2); \
    VRD(3); SBAR(); GAPA(C0=__builtin_amdgcn_mfma_f32_32x32x16_bf16(kf[6],qr[3],C0,0,0,0),   P1[10],P1[11],P1[12],P1[13], pw3[0]=PKW(P1,8), pw3[1]=PKW(P1,10), pw3); \
    VRD(7); SBAR(); GAPA(C1=__builtin_amdgcn_mfma_f32_32x32x16_bf16(kf[7],qr[3],C1,0,0,0),   P1[14],P1[15],0.f,0.f,       pw3[2]=PKW(P1,12),pw3[3]=PKW(P1,14), pw3); \
    l_reg+=sacc; \
    if(GK){DMA_K((t)+3,sl_cur);} if(GV){DMA_V((t)+1,sl_next);} \
    CMASK(C0,C1,t); \
    { float a=MX3(C0[0],C0[1],C1[0]),b=MX3(C0[2],C0[3],C1[1]); a=MX3(a,C1[2],C1[3]); \
      _Pragma("unroll") for(int r=4;r<16;r+=4){a=MX3(a,C0[r],C0[r+1]);b=MX3(b,C0[r+2],C0[r+3]);a=MX3(a,C1[r],C1[r+1]);b=MX3(b,C1[r+2],C1[r+3]);} \
      float rm=__builtin_fmaxf(a,b); { auto rr=__builtin_amdgcn_permlane32_swap(__float_as_uint(rm),__float_as_uint(rm),false,false); rm=__builtin_fmaxf(__uint_as_float(rr[0]),__uint_as_float(rr[1])); } \
      resc=false; \
      if(__builtin_expect(__any(rm>(float)THRL),0)){ const float dl=__builtin_fmaxf(rm,0.f); mhat+=dl; \
        _Pragma("unroll") for(int r=0;r<16;++r){C0[r]-=dl;C1[r]-=dl;} \
        _Pragma("unroll") for(int r=0;r<16;++r)negm[r]=-mhat; asm volatile("":"+v"(negm)); \
        const float f=__builtin_amdgcn_exp2f(-dl); l_reg*=f; if(hi==0)wsf[r32]=f; resc=true; } } \
    SBAR(); \
    GAPB(o[0]=__builtin_amdgcn_mfma_f32_32x32x16_bf16(PAF(0),VFR(0),o[0],0,0,0), C0,0); \
    GAPB(o[1]=__builtin_amdgcn_mfma_f32_32x32x16_bf16(PAF(0),VFR(4),o[1],0,0,0), C0,4); \
    KRD(GL,0); GAPB(o[0]=__builtin_amdgcn_mfma_f32_32x32x16_bf16(PAF(1),VFR(1),o[0],0,0,0), C0,8); \
    KRD(GL,1); GAPB(o[1]=__builtin_amdgcn_mfma_f32_32x32x16_bf16(PAF(1),VFR(5),o[1],0,0,0), C0,12); \
    KRD(GL,2); GAPB(o[0]=__builtin_amdgcn_mfma_f32_32x32x16_bf16(PAF(2),VFR(2),o[0],0,0,0), C1,0); \
    KRD(GL,3); GAPB(o[1]=__builtin_amdgcn_mfma_f32_32x32x16_bf16(PAF(2),VFR(6),o[1],0,0,0), C1,4); \
    GAPB(o[0]=__builtin_amdgcn_mfma_f32_32x32x16_bf16(PAF(3),VFR(3),o[0],0,0,0), C1,8); \
    GAPB(o[1]=__builtin_amdgcn_mfma_f32_32x32x16_bf16(PAF(3),VFR(7),o[1],0,0,0), C1,12); \
    }while(0)
  int t=1;
  #undef CMASK
  #define CMASK(P0,P1,t) do{}while(0)
  for(;t+5<NT;t+=2){
    STEP(pB0,pB1,pA0,pA1,t,true,true,true);     WAIT_BAR(2); RESC(); ROT();
    STEP(pA0,pA1,pB0,pB1,t+1,true,true,true);   WAIT_BAR(2); RESC(); ROT();
  }
  #undef CMASK
  #define CMASK(P0,P1,t) do{int jb_=(t)-(NT-4); if(jb_>=0)cmask(P0,P1,jb_,qrel,hi);}while(0)
  #define ENDW(tt) do{ if((tt)+3<NT){WAIT_BAR(2);} else if((tt)+2<NT){WAIT_BAR(1);} else {WAIT_BAR(0);} }while(0)
  for(;t+1<NT;t+=2){
    STEP(pB0,pB1,pA0,pA1,t,(t+3<NT),(t+1<NT),(t+1<NT));       ENDW(t);   RESC(); ROT();
    STEP(pA0,pA1,pB0,pB1,t+1,(t+4<NT),(t+2<NT),(t+2<NT));     ENDW(t+1); RESC(); ROT();
  }
  STEP(pB0,pB1,pA0,pA1,NT-1,false,false,false); RESC();
  { float sacc=pB0[0]+pB0[1]; _Pragma("unroll") for(int r=2;r<16;++r)sacc+=pB0[r]; _Pragma("unroll") for(int r=0;r<16;++r)sacc+=pB1[r]; l_reg+=sacc;
    pw0=(u32x4){PKW(pB0,0),PKW(pB0,2),PKW(pB0,4),PKW(pB0,6)};pw1=(u32x4){PKW(pB0,8),PKW(pB0,10),PKW(pB0,12),PKW(pB0,14)};pw2=(u32x4){PKW(pB1,0),PKW(pB1,2),PKW(pB1,4),PKW(pB1,6)};pw3=(u32x4){PKW(pB1,8),PKW(pB1,10),PKW(pB1,12),PKW(pB1,14)};
    SBAR(); pv(o,vb0+sl_cur,PAF(0),PAF(1),PAF(2),PAF(3)); }
  #undef PKW
  #undef PAF
  #undef VFR
  #undef PIN
  #undef MX3
  #undef GAPA
  #undef GAPB
  #undef EX
  #undef VRD
  #undef KRD
  #undef STEP
  #undef ENDW
  {auto rr=__builtin_amdgcn_permlane32_swap(__float_as_uint(l_reg),__float_as_uint(l_reg),false,false);l_reg=__uint_as_float(rr[0])+__uint_as_float(rr[1]);}
  if(hi==0)wsf[32+r32]=l_reg;asm volatile("s_waitcnt lgkmcnt(0)":::"memory");
  float rli[16];
  #pragma unroll
  for(int r=0;r<16;++r)rli[r]=__builtin_amdgcn_rcpf(wsf[32+crow(r,hi)]);
  bf16*Ow=Oh+(rowbase+q0+wid*QBLK)*(long)op;
  { bf16*stg=(bf16*)(shm+LDS_OST)+wid*2048;
    #pragma unroll
    for(int r=0;r<16;++r){const int orow=crow(r,hi);
      #pragma unroll
      for(int d0=0;d0<2;++d0)stg[orow*64+d0*32+r32]=__float2bfloat16(o[d0][r]*rli[r]);}
    asm volatile("s_waitcnt lgkmcnt(0)":::"memory");
    #pragma unroll
    for(int i=0;i<4;++i){const int row=i*8+(lane>>3),ch=lane&7; const u32x4 v=*(const u32x4*)(stg+row*64+ch*8); ATTN_STORE16(Ow+(long)row*op+ch*8,v);} }
  asm volatile("s_waitcnt lgkmcnt(0)\n\ts_barrier":::"memory");
  #undef DMA_K
  #undef DMA_V
  #undef CMASK
  #undef START
  #undef RESC
  #undef ROT
  #undef LDBIAS
}
constexpr int ATTN_LDS_BYTES=LDS_BYTES;
#undef SBAR
#undef WAIT_BAR
}

constexpr int BATCH = 8, SEQ = 2048, DM = 1024, M_TOK = BATCH * SEQ, DEPTH = 4;
constexpr int D_IN = 6664, C_FF = 3584, C_GL = 3592;
constexpr int PP = 3584;
constexpr int NGL = 3072;
constexpr float ALPHA = 1.681792830507429f;
constexpr float LN_EPS = 1e-5f, RMS_EPS = 1e-6f;
constexpr float LOG2E = 1.4426950408889634f;
constexpr float C2 = 0.125f * LOG2E;

typedef unsigned short bf16;
typedef unsigned v4u __attribute__((ext_vector_type(4)));
typedef float f32x4 __attribute__((ext_vector_type(4)));
#define LAS __attribute__((address_space(3)))
#define LDS_WAIT() asm volatile("s_waitcnt lgkmcnt(0)" ::: "memory")
__device__ __forceinline__ unsigned f2bf(float f) { unsigned u = __builtin_bit_cast(unsigned, f); return (u + 0x7fffu + ((u >> 16) & 1u)) >> 16; }
__device__ __forceinline__ unsigned pk2(float lo, float hi) { return f2bf(lo) | (f2bf(hi) << 16); }
__device__ __forceinline__ float bf2f(bf16 v) { return __builtin_bit_cast(float, (unsigned)v << 16); }
__device__ __forceinline__ float wave_sum(float v) {
#define WS_DPP(ctrl) v += __builtin_bit_cast(float, __builtin_amdgcn_update_dpp(0, __builtin_bit_cast(int, v), ctrl, 0xf, 0xf, true))
    WS_DPP(0xB1); WS_DPP(0x4E); WS_DPP(0x141); WS_DPP(0x140);
#undef WS_DPP
    v += __builtin_bit_cast(float, __builtin_amdgcn_ds_swizzle(__builtin_bit_cast(int, v), 0x401F));
    return __builtin_bit_cast(float, __builtin_amdgcn_readlane(__builtin_bit_cast(int, v), 0)) + __builtin_bit_cast(float, __builtin_amdgcn_readlane(__builtin_bit_cast(int, v), 32));
}
__device__ __forceinline__ float wave_max(float v) {
#pragma unroll
    for (int o = 1; o < 64; o <<= 1) v = fmaxf(v, __shfl_xor(v, o));
    return v;
}
__device__ __forceinline__ float sigmoidf_(float z) { return 1.f / (1.f + __expf(-z)); }
__device__ __forceinline__ float gelu_tanh(float y) { const float u = 0.7978845608028654f * (y + 0.044715f * y * y * y); return 0.5f * y * (1.f + tanhf(u)); }

constexpr size_t MiB = 1u << 20;
constexpr size_t WS_CTL = 0;
constexpr size_t WS_WIN = 1 * MiB;
constexpr size_t WS_WB = 14 * MiB;
constexpr size_t WS_WO = 17 * MiB;
constexpr size_t WS_WGLU = 19 * MiB;
constexpr size_t WS_WG = 20 * MiB;
constexpr size_t WS_WU = 28 * MiB;
constexpr size_t WS_WD = 36 * MiB;
constexpr size_t WS_ROPE = 44 * MiB;
constexpr size_t WS_XB = 45 * MiB;
constexpr size_t WS_PROJ = 77 * MiB;
constexpr size_t WS_GL = 189 * MiB;
constexpr size_t WS_GY = 285 * MiB;
constexpr size_t WS_BR = 301 * MiB;
constexpr size_t WS_OD = 349 * MiB;
constexpr size_t WS_CB = 381 * MiB;
constexpr size_t WS_LOGF = 382 * MiB;
constexpr size_t WS_ROUTE = 383 * MiB;
constexpr size_t WS_TOKL = 384 * MiB;
constexpr size_t WS_WL = 385 * MiB;
constexpr size_t WS_TSLOT = 386 * MiB;
constexpr size_t WS_SMT = 387 * MiB;
constexpr size_t WS_SW2 = 391 * MiB;
constexpr size_t WS_SW3 = 393 * MiB;
constexpr size_t WS_SAL = 395 * MiB;
constexpr size_t WS_END = 396 * MiB;
constexpr size_t WS_P = WS_PROJ;
constexpr size_t WS_MG = WS_PROJ;
constexpr size_t WS_MIX = WS_GL;
constexpr size_t WS_HG = WS_PROJ;
constexpr size_t WS_HU = WS_PROJ + 32 * MiB;
constexpr size_t WS_FF = WS_GL;
constexpr size_t WS_H = WS_GY;
constexpr size_t WS_Y = WS_PROJ;

template <class Epi> __global__ void __launch_bounds__(512, 2) gemm_kernel(pg8::Gemm g, Epi E) {
    extern __shared__ __attribute__((aligned(16))) unsigned char lds[];
    pg8::StaticOrder S; S.init(g.M, g.N, (int)gridDim.x, (int)blockIdx.x);
    pg8::gemm_phase<Epi, pg8::StaticOrder, true, true>((PG8_LAS unsigned char*)lds, g, S, E);
}

__global__ void k_cast_bf16(const float* __restrict__ x, bf16* __restrict__ o, size_t n4) {
    for (size_t i = (size_t)blockIdx.x * blockDim.x + threadIdx.x; i < n4; i += (size_t)gridDim.x * blockDim.x) {
        const f32x4 v = ((const f32x4*)x)[i]; uint2 w; w.x = pk2(v.x, v.y); w.y = pk2(v.z, v.w); ((uint2*)o)[i] = w; }
}
__global__ void k_ropetab(float* tab) {
    const int idx = blockIdx.x * blockDim.x + threadIdx.x; if (idx >= SEQ * 32) return;
    const int s = idx >> 5, i = idx & 31;
    const float inv_freq = exp2f(-(float)(2 * i) * (13.287712379549449f / 64.0f));
    const float ang = (float)s * inv_freq;
    const double rev = (double)ang * 0.15915494309189535; const double fr = rev - __builtin_floor(rev + 0.5);
    const float a = (float)(fr * 6.283185307179586);
    tab[idx] = cosf(a); tab[SEQ * 32 + idx] = sinf(a);
}
__global__ void k_rope(bf16* __restrict__ P, const float* __restrict__ tab) {
    const size_t idx = (size_t)blockIdx.x * blockDim.x + threadIdx.x; if (idx >= (size_t)M_TOK * 16 * 32) return;
    const int d = idx & 31, hh = (idx >> 5) & 15; const size_t t = idx >> 9; const int s = (int)(t % SEQ);
    bf16* p = P + t * PP + 512 + hh * 64 + d;
    const float t1 = bf2f(p[0]), t2 = bf2f(p[32]), cs = tab[s * 32 + d], sn = tab[SEQ * 32 + s * 32 + d];
    p[0] = (bf16)f2bf(t1 * cs - t2 * sn); p[32] = (bf16)f2bf(t2 * cs + t1 * sn);
}
__global__ void __launch_bounds__(256) k_fgate(const float* __restrict__ x, const float* __restrict__ w_in, const float* __restrict__ fbias, float* __restrict__ logf) {
    const int lane = threadIdx.x & 63, gw = blockIdx.x * 4 + (threadIdx.x >> 6), NGW = gridDim.x * 4;
    for (int t = gw; t < M_TOK; t += NGW) {
        float acc[8];
#pragma unroll
        for (int h = 0; h < 8; ++h) acc[h] = 0.f;
#pragma unroll
        for (int j = 0; j < 4; ++j) { const int k0 = 4 * lane + 256 * j; const f32x4 xv = *(const f32x4*)(x + (size_t)t * DM + k0);
#pragma unroll
            for (int c = 0; c < 4; ++c) { const float* wr = w_in + (size_t)(k0 + c) * D_IN + C_FF; const f32x4 w0 = *(const f32x4*)wr, w1 = *(const f32x4*)(wr + 4); const float xs = xv[c];
                acc[0] += xs * w0.x; acc[1] += xs * w0.y; acc[2] += xs * w0.z; acc[3] += xs * w0.w; acc[4] += xs * w1.x; acc[5] += xs * w1.y; acc[6] += xs * w1.z; acc[7] += xs * w1.w; } }
        const int b = t / SEQ, s = t % SEQ;
#pragma unroll
        for (int h = 0; h < 8; ++h) { const float z = wave_sum(acc[h]) + fbias[h]; const float ls = fminf(z, 0.f) - log1pf(__expf(-fabsf(z)));
            if (lane == h) logf[((size_t)(b * 8 + h)) * SEQ + s] = ls; }
    }
}
__global__ void __launch_bounds__(64) k_cumsum(const float* __restrict__ logf, float* __restrict__ cb) {
    const int lane = threadIdx.x; const size_t base = (size_t)blockIdx.x * SEQ + lane * 32;
    float v[32]; float run = 0.f;
#pragma unroll
    for (int i = 0; i < 32; ++i) { run += logf[base + i]; v[i] = run; }
    float incl = run;
#pragma unroll
    for (int o = 1; o < 64; o <<= 1) { const float n = __shfl_up(incl, o); if (lane >= o) incl += n; }
    const float off = incl - run;
#pragma unroll
    for (int i = 0; i < 32; ++i) cb[base + i] = v[i] + off;
}
__global__ void __launch_bounds__(64) k_ssm(const bf16* __restrict__ PROJ, const float* __restrict__ lam_re, const float* __restrict__ lam_im, const float* __restrict__ log_dt,
                                              const float* __restrict__ b_re, const float* __restrict__ b_im, const float* __restrict__ c_re, const float* __restrict__ c_im,
                                              const float* __restrict__ dsk, bf16* __restrict__ GY) {
    const int p = threadIdx.x, b = blockIdx.x >> 5, g = blockIdx.x & 31;
    const float lr = lam_re[g * 64 + p], li = lam_im[g * 64 + p], dt = expf(log_dt[g]);
    const float mag = expf(lr * dt), ang = li * dt, ar = mag * cosf(ang), ai = mag * sinf(ang);
    const float er = ar - 1.f, ei = ai, den = lr * lr + li * li, qr = (er * lr + ei * li) / den, qi = (ei * lr - er * li) / den;
    float bbr[16], bbi[16], cr[16], ci[16];
#pragma unroll
    for (int n = 0; n < 16; ++n) { const float br = b_re[(g * 64 + p) * 16 + n], bi = b_im[(g * 64 + p) * 16 + n]; bbr[n] = qr * br - qi * bi; bbi[n] = qr * bi + qi * br;
        cr[n] = c_re[(g * 16 + n) * 64 + p]; ci[n] = c_im[(g * 16 + n) * 64 + p]; }
    const float dn = dsk[g * 16 + (p & 15)];
    float xr = 0.f, xi = 0.f;
    const bf16* up = PROJ + (size_t)b * SEQ * PP + g * 16;
    for (int s = 0; s < SEQ; ++s) {
        const v4u u0 = *(const v4u*)(up + (size_t)s * PP), u1 = *(const v4u*)(up + (size_t)s * PP + 8);
        float u[16];
        u[0] = __builtin_bit_cast(float, u0.x << 16); u[1] = __builtin_bit_cast(float, u0.x & 0xffff0000u); u[2] = __builtin_bit_cast(float, u0.y << 16); u[3] = __builtin_bit_cast(float, u0.y & 0xffff0000u);
        u[4] = __builtin_bit_cast(float, u0.z << 16); u[5] = __builtin_bit_cast(float, u0.z & 0xffff0000u); u[6] = __builtin_bit_cast(float, u0.w << 16); u[7] = __builtin_bit_cast(float, u0.w & 0xffff0000u);
        u[8] = __builtin_bit_cast(float, u1.x << 16); u[9] = __builtin_bit_cast(float, u1.x & 0xffff0000u); u[10] = __builtin_bit_cast(float, u1.y << 16); u[11] = __builtin_bit_cast(float, u1.y & 0xffff0000u);
        u[12] = __builtin_bit_cast(float, u1.z << 16); u[13] = __builtin_bit_cast(float, u1.z & 0xffff0000u); u[14] = __builtin_bit_cast(float, u1.w << 16); u[15] = __builtin_bit_cast(float, u1.w & 0xffff0000u);
        float bur = 0.f, bui = 0.f;
#pragma unroll
        for (int n = 0; n < 16; ++n) { bur += bbr[n] * u[n]; bui += bbi[n] * u[n]; }
        const float nxr = ar * xr - ai * xi + bur, nxi = ar * xi + ai * xr + bui; xr = nxr; xi = nxi;
        float mine = 0.f, un = 0.f;
#pragma unroll
        for (int n = 0; n < 16; ++n) { const float y = wave_sum(cr[n] * xr - ci[n] * xi); if ((p & 15) == n) { mine = y; un = u[n]; } }
        if (p < 16) GY[((size_t)b * SEQ + s) * 512 + g * 16 + p] = (bf16)f2bf(gelu_tanh(mine + dn * un));
    }
}
__global__ void k_glu(const bf16* __restrict__ Z, bf16* __restrict__ YS) {
    const size_t idx = (size_t)blockIdx.x * blockDim.x + threadIdx.x; if (idx >= (size_t)M_TOK * 512) return;
    const size_t t = idx >> 9; const int j = idx & 511;
    const float v = bf2f(Z[t * 1024 + j]), gt = bf2f(Z[t * 1024 + 512 + j]);
    YS[idx] = (bf16)f2bf(v * sigmoidf_(gt));
}
struct AttnArgs { const bf16* Q; const bf16* K; const bf16* V; const float* CB; bf16* O; int qpitch, qcol0, kpitch, kcol0, vpitch, vcol0, vhstride, vdiv, opitch, ocol0, ohstride, ocstride, nheads, pad; float qscale, pad2; };
template <int VD> __global__ void __launch_bounds__(256) k_attn(AttnArgs a) {
    __shared__ float sc[4][SEQ];
    const int lane = threadIdx.x & 63, w = threadIdx.x >> 6;
    int bid = blockIdx.x; const int ig = bid % (SEQ / 4); bid /= (SEQ / 4); const int h = bid % a.nheads, b = bid / a.nheads;
    const int i = ig * 4 + w; const size_t t0 = (size_t)b * SEQ;
    float q[64];
    { const bf16* qp = a.Q + (t0 + i) * a.qpitch + a.qcol0 + h * 64;
#pragma unroll
      for (int d = 0; d < 64; ++d) q[d] = bf2f(qp[d]) * a.qscale; }
    const float* cbp = a.CB ? a.CB + (size_t)(b * a.nheads + h) * SEQ : nullptr;
    const float cq = cbp ? cbp[i] : 0.f;
    float m = -INFINITY;
    for (int j = lane; j <= i; j += 64) {
        const bf16* kp = a.K + (t0 + j) * a.kpitch + a.kcol0 + h * 64; float s = 0.f;
#pragma unroll
        for (int c = 0; c < 8; ++c) { const v4u kv = *(const v4u*)(kp + 8 * c);
            s += q[8 * c + 0] * __builtin_bit_cast(float, kv.x << 16) + q[8 * c + 1] * __builtin_bit_cast(float, kv.x & 0xffff0000u) + q[8 * c + 2] * __builtin_bit_cast(float, kv.y << 16) + q[8 * c + 3] * __builtin_bit_cast(float, kv.y & 0xffff0000u)
               + q[8 * c + 4] * __builtin_bit_cast(float, kv.z << 16) + q[8 * c + 5] * __builtin_bit_cast(float, kv.z & 0xffff0000u) + q[8 * c + 6] * __builtin_bit_cast(float, kv.w << 16) + q[8 * c + 7] * __builtin_bit_cast(float, kv.w & 0xffff0000u); }
        if (cbp) s += (cq - cbp[j]) * LOG2E;
        sc[w][j] = s; m = fmaxf(m, s);
    }
    m = wave_max(m);
    __syncthreads();
    float l = 0.f;
    for (int j = lane; j <= i; j += 64) { const float p = exp2f(sc[w][j] - m); sc[w][j] = p; l += p; }
    l = wave_sum(l);
    __syncthreads();
    const int vh = h / a.vdiv, vc = h % a.vdiv;
    const bf16* vp = a.V + t0 * a.vpitch + a.vcol0 + vh * a.vhstride + lane;
    float o0 = 0.f, o1 = 0.f;
    for (int j = 0; j <= i; ++j) { const float p = sc[w][j]; o0 += p * bf2f(vp[(size_t)j * a.vpitch]); if (VD == 128) o1 += p * bf2f(vp[(size_t)j * a.vpitch + 64]); }
    bf16* op = a.O + (t0 + i) * a.opitch + a.ocol0 + vh * a.ohstride + vc * a.ocstride + lane;
    const float rl = 1.f / l;
    op[0] = (bf16)f2bf(o0 * rl); if (VD == 128) op[64] = (bf16)f2bf(o1 * rl);
}
__global__ void __launch_bounds__(256) k_diffcombine(const bf16* __restrict__ OD, const float* __restrict__ lam, const float* __restrict__ gnorm, float lam_init, bf16* __restrict__ YD) {
    const int lane = threadIdx.x & 63, gw = blockIdx.x * 4 + (threadIdx.x >> 6);
    if (gw >= M_TOK * 4) return;
    const int t = gw >> 2, h = gw & 3;
    const float s01 = wave_sum(lam[lane] * lam[64 + lane]), s23 = wave_sum(lam[128 + lane] * lam[192 + lane]);
    const float lam_full = expf(s01) - expf(s23) + lam_init;
    const bf16* o0 = OD + (size_t)t * 1024 + h * 128, *o1 = o0 + 512;
    const float a0 = bf2f(o0[lane]) - lam_full * bf2f(o1[lane]), a1 = bf2f(o0[lane + 64]) - lam_full * bf2f(o1[lane + 64]);
    const float ss = wave_sum(a0 * a0 + a1 * a1);
    const float r = rsqrtf(ss * (1.f / 128.f) + RMS_EPS) * (1.f - lam_init);
    YD[(size_t)t * 512 + h * 128 + lane] = (bf16)f2bf(a0 * r * gnorm[h * 128 + lane]);
    YD[(size_t)t * 512 + h * 128 + lane + 64] = (bf16)f2bf(a1 * r * gnorm[h * 128 + lane + 64]);
}
__global__ void k_merge(const bf16* __restrict__ GL, const bf16* __restrict__ P, bf16* __restrict__ MG) {
    const size_t idx = (size_t)blockIdx.x * blockDim.x + threadIdx.x; if (idx >= (size_t)M_TOK * DM) return;
    const size_t t = idx >> 10; const int d = idx & 1023; float acc = 0.f;
#pragma unroll
    for (int n = 0; n < 3; ++n) acc += bf2f(GL[t * NGL + n * 1024 + d]) * bf2f(P[(size_t)n * M_TOK * DM + idx]);
    MG[idx] = (bf16)f2bf(acc);
}
__device__ __forceinline__ void ln_rows(const float* xin, const float* __restrict__ add, const float* __restrict__ g, const float* __restrict__ bta, float* xo, bf16* __restrict__ xb,
                                             const float* __restrict__ w_g, const float* __restrict__ b_g, const float* __restrict__ w_e, const float* __restrict__ b_e, float* __restrict__ gate, int gw, int NGW, int lane) {
    for (int t = gw; t < M_TOK; t += NGW) {
        f32x4 v[4]; float s = 0.f;
#pragma unroll
        for (int j = 0; j < 4; ++j) { const size_t o = (size_t)t * DM + 4 * lane + 256 * j; v[j] = ALPHA * *(const f32x4*)(xin + o) + *(const f32x4*)(add + o); s += (v[j].x + v[j].y) + (v[j].z + v[j].w); }
        const float mean = wave_sum(s) * (1.f / DM); float s2 = 0.f;
#pragma unroll
        for (int j = 0; j < 4; ++j) { v[j] = v[j] - mean; s2 += (v[j].x * v[j].x + v[j].y * v[j].y) + (v[j].z * v[j].z + v[j].w * v[j].w); }
        const float rstd = rsqrtf(wave_sum(s2) * (1.f / DM) + LN_EPS);
#pragma unroll
        for (int j = 0; j < 4; ++j) { const int c = 4 * lane + 256 * j; const size_t o = (size_t)t * DM + c; v[j] = v[j] * rstd * *(const f32x4*)(g + c) + *(const f32x4*)(bta + c);
            *(f32x4*)(xo + o) = v[j]; uint2 w; w.x = pk2(v[j].x, v[j].y); w.y = pk2(v[j].z, v[j].w); *(uint2*)(xb + o) = w; }
        if (gate) {
            float lg[4], le[16];
#pragma unroll
            for (int q = 0; q < 4; ++q) lg[q] = 0.f;
#pragma unroll
            for (int q = 0; q < 16; ++q) le[q] = 0.f;
#pragma unroll
            for (int j = 0; j < 4; ++j)
#pragma unroll
                for (int c = 0; c < 4; ++c) { const int k = 4 * lane + 256 * j + c; const float xs = v[j][c]; const f32x4 wg = *(const f32x4*)(w_g + (size_t)k * 4);
                    lg[0] += xs * wg.x; lg[1] += xs * wg.y; lg[2] += xs * wg.z; lg[3] += xs * wg.w;
#pragma unroll
                    for (int q = 0; q < 4; ++q) { const f32x4 we = *(const f32x4*)(w_e + (size_t)k * 16 + 4 * q); le[4 * q] += xs * we.x; le[4 * q + 1] += xs * we.y; le[4 * q + 2] += xs * we.z; le[4 * q + 3] += xs * we.w; } }
#pragma unroll
            for (int q = 0; q < 4; ++q) lg[q] = wave_sum(lg[q]) + b_g[q];
#pragma unroll
            for (int q = 0; q < 16; ++q) le[q] = wave_sum(le[q]) + b_e[q];
            int gi = 0; float gm = lg[0];
#pragma unroll
            for (int q = 1; q < 4; ++q) if (lg[q] > gm) { gm = lg[q]; gi = q; }
            float den = 0.f;
#pragma unroll
            for (int q = 0; q < 4; ++q) den += __expf(lg[q] - gm);
            const float gp = 1.f / den;
            float sel[4];
#pragma unroll
            for (int q = 0; q < 4; ++q) sel[q] = gi == 0 ? le[q] : gi == 1 ? le[4 + q] : gi == 2 ? le[8 + q] : le[12 + q];
            int i0 = 0; float v0 = sel[0];
#pragma unroll
            for (int q = 1; q < 4; ++q) if (sel[q] > v0) { v0 = sel[q]; i0 = q; }
            int i1 = -1; float v1 = -INFINITY;
#pragma unroll
            for (int q = 0; q < 4; ++q) if (q != i0 && sel[q] > v1) { v1 = sel[q]; i1 = q; }
            const float e1 = __expf(v1 - v0), w0 = gp / (1.f + e1), w1 = gp * e1 / (1.f + e1);
            const int E0 = gi * 4 + i0, E1 = gi * 4 + i1;
            if (lane < 16) gate[(size_t)t * 16 + lane] = (lane == E0 ? w0 : 0.f) + (lane == E1 ? w1 : 0.f);
        }
    }
}
__global__ void __launch_bounds__(256) k_ln(const float* xin, const float* __restrict__ add, const float* __restrict__ g, const float* __restrict__ bta, float* xo, bf16* __restrict__ xb,
                                             const float* __restrict__ w_g, const float* __restrict__ b_g, const float* __restrict__ w_e, const float* __restrict__ b_e, float* __restrict__ gate) {
    ln_rows(xin, add, g, bta, xo, xb, w_g, b_g, w_e, b_e, gate, blockIdx.x * 4 + (threadIdx.x >> 6), gridDim.x * 4, threadIdx.x & 63);
}
__global__ void k_moe_hidden(bf16* __restrict__ HG, const bf16* __restrict__ HU, const float* __restrict__ gate, int r0) {
    const size_t idx = (size_t)blockIdx.x * blockDim.x + threadIdx.x; if (idx >= (size_t)4096 * 4096) return;
    const int r = (int)(idx >> 12), c = (int)(idx & 4095); const float gt = gate[(size_t)(r0 + r) * 16 + (c >> 8)];
    float hv = 0.f;
    if (gt != 0.f) { const float a = bf2f(HG[idx]), u = bf2f(HU[idx]); hv = a * sigmoidf_(a) * u * gt; }
    HG[idx] = (bf16)f2bf(hv);
}


typedef __attribute__((address_space(1))) unsigned gu32;
#define RLX_AGENT __ATOMIC_RELAXED, __HIP_MEMORY_SCOPE_AGENT
constexpr int NWAVES = 8;
constexpr int RING_BYTES = 139264;
constexpr int MISC_OFF = RING_BYTES;
constexpr int LDS_BYTES = RING_BYTES + 2048;
constexpr int CW_CNT = 8192;
constexpr int CW_BAR = 4096;
constexpr int MAX_BAR_REGIONS = 64;
constexpr size_t CTL_ZERO_BYTES = 1 * MiB;
#define XB_TMO      128
#define XB_XCNT(j)  (256  + 64 * (j))
#define XB_XSUB(j)  (1280 + 64 * (j))
#define XB_XGEN(j)  (2304 + 64 * (j))
#define XB_TOP      3328
#define XB_TOPGEN   3392
#define XCD_BAR_WORDS 3456
#define XB_SPIN_CAP (1u << 24)

__device__ __forceinline__ unsigned xb_ld(unsigned* p)              { return __hip_atomic_load(p, __ATOMIC_RELAXED, __HIP_MEMORY_SCOPE_AGENT); }
__device__ __forceinline__ unsigned xb_add(unsigned* p, unsigned v) { return __hip_atomic_fetch_add(p, v, __ATOMIC_RELAXED, __HIP_MEMORY_SCOPE_AGENT); }
__device__ __forceinline__ unsigned xb_xcc_id() { return (unsigned)__builtin_amdgcn_s_getreg((3 << 11) | 20) & 0xFu; }
#define XB_SPIN(cond, bar) do { unsigned _sp = 0; while (cond) { __builtin_amdgcn_s_sleep(1); \
    if ((++_sp & 255u) == 0u) { if (xb_ld(&(bar)[XB_TMO])) break; if (_sp > XB_SPIN_CAP) { atomicAdd(&(bar)[XB_TMO], 1u); break; } } } } while (0)

struct XcdBarrier {
    unsigned* bar; unsigned x;
    volatile LAS unsigned* st;
};

__device__ __forceinline__ XcdBarrier xcd_barrier_post(unsigned* bar, volatile LAS unsigned* st) {
    XcdBarrier b; b.bar = bar; b.x = xb_xcc_id(); b.st = st;
    if (threadIdx.x == 0) (void)xb_add(&bar[XB_XCNT(b.x)], 1u);
    return b;
}
__device__ __forceinline__ void xcd_barrier_complete(unsigned* bar, unsigned x, unsigned& nloc, unsigned& nx) {
    const unsigned G = gridDim.x * gridDim.y * gridDim.z;
    unsigned sum, cnt, mine, sp = 0u;
    for (;;) {
        sum = 0u; cnt = 0u; mine = 0u;
#pragma unroll 1
        for (unsigned j = 0; j < 16; ++j) { const unsigned c = xb_ld(&bar[XB_XCNT(j)]); sum += c; cnt += (c > 0u) ? 1u : 0u; }
        if (sum == G) { mine = xb_ld(&bar[XB_XCNT(x)]); break; }
        __builtin_amdgcn_s_sleep(1);
        if ((++sp & 255u) == 0u) { if (xb_ld(&bar[XB_TMO])) { mine = xb_ld(&bar[XB_XCNT(x)]); break; } if (sp > XB_SPIN_CAP) { atomicAdd(&bar[XB_TMO], 1u); mine = xb_ld(&bar[XB_XCNT(x)]); break; } }
    }
    nloc = mine > 0u ? mine : 1u; nx = cnt > 0u ? cnt : 1u;
}

__device__ __forceinline__ void xcd_barrier(const XcdBarrier& b) {
    asm volatile("s_waitcnt vmcnt(0)" ::: "memory");
    __syncthreads();
    if (threadIdx.x == 0) {
        unsigned* bar = b.bar; asm volatile("" : "+s"(bar));
        __builtin_amdgcn_s_waitcnt(0);
        unsigned nloc = b.st[0], nx = b.st[1];
        if (nloc == 0u) { xcd_barrier_complete(bar, b.x, nloc, nx); b.st[0] = nloc; b.st[1] = nx; }
        const unsigned old = xb_add(&bar[XB_XSUB(b.x)], 1u);
        const unsigned gen = old / nloc;
        if (old + 1u == (gen + 1u) * nloc) {
            __builtin_amdgcn_fence(__ATOMIC_RELEASE, "agent");
            asm volatile("s_waitcnt vmcnt(0)" ::: "memory");
            const unsigned og = xb_add(&bar[XB_TOP], 1u);
            const unsigned tg = og / nx;
            if (og + 1u == (tg + 1u) * nx) xb_add(&bar[XB_TOPGEN], 1u);
            else XB_SPIN(xb_ld(&bar[XB_TOPGEN]) == tg, bar);
            __builtin_amdgcn_fence(__ATOMIC_ACQUIRE, "agent");
            xb_add(&bar[XB_XGEN(b.x)], 1u);
            asm volatile("s_waitcnt vmcnt(0)" ::: "memory");
        } else {
            XB_SPIN(xb_ld(&bar[XB_XGEN(b.x)]) == gen, bar);
            __builtin_amdgcn_fence(__ATOMIC_ACQUIRE, "agent");
            asm volatile("s_waitcnt vmcnt(0)" ::: "memory");
        }
    }
    __syncthreads();
}

struct ConvJob { const float* src; bf16* dst; long src_lstride, src_bstride, dst_bstride; int K, N, ld_src, col0, nbatch, dst_ld, item0, mode; };
constexpr int MAX_JOBS = 12;
struct ConvArgs { ConvJob j[MAX_JOBS]; int njobs, nitems, nitemsA, pad; };
__device__ __forceinline__ int conv_src_col(int mode, int n) {
    if (mode == 1) { const int p = n & 63; return (n & ~63) + 4 * (p >> 3) + (p & 3) + 32 * ((p >> 2) & 1); }
    if (mode == 2) { const int t = n >> 8, p = n & 255; return 512 * ((p >> 2) & 1) + 128 * t + 4 * (p >> 3) + (p & 3); }
    return n;
}
__device__ __forceinline__ int conv_dst_row(int mode, int n) {
    if (mode == 3 || mode == 4) return 256 * (n >> 7) + 8 * ((n & 127) >> 2) + (n & 3) + (mode == 4 ? 4 : 0);
    return n;
}
#define CAS __attribute__((address_space(4)))
__device__ __forceinline__ void conv_item(const CAS ConvArgs& A, int layer, int it, LAS float* scr, int lane) {
    int js = 0; const int nj = A.njobs;
#pragma unroll 1
    for (int q = 1; q < nj; ++q) if (it >= A.j[q].item0) js = q;
    const CAS ConvJob& J = A.j[js];
    int r = it - J.item0; const int nblk = J.N / 32, per_b = (J.K / 64) * nblk;
    const int bt = r / per_b; r -= bt * per_b; const int kb = r / nblk, nb = r % nblk, k0 = 64 * kb, n0 = 32 * nb;
    const float* W = J.src + (size_t)layer * J.src_lstride + (size_t)bt * J.src_bstride + J.col0 + conv_src_col(J.mode, n0 + (lane & 31)); bf16* WT = J.dst + (size_t)bt * J.dst_bstride;
    const int ld = J.ld_src, dld = J.dst_ld;
#pragma unroll 8
    for (int i = 0; i < 32; ++i) { const int kk = 2 * i + (lane >> 5); scr[kk * 33 + (lane & 31)] = W[(size_t)(k0 + kk) * ld]; }
    LDS_WAIT(); asm volatile("" ::: "memory");
    const int c = lane & 7;
#pragma unroll
    for (int jj = 0; jj < 4; ++jj) { const int n = (lane >> 3) + 8 * jj; const LAS float* s = scr + (8 * c) * 33 + n;
        v4u o; o.x = pk2(s[0 * 33], s[1 * 33]); o.y = pk2(s[2 * 33], s[3 * 33]); o.z = pk2(s[4 * 33], s[5 * 33]); o.w = pk2(s[6 * 33], s[7 * 33]);
        *(v4u*)(WT + (size_t)conv_dst_row(J.mode, n0 + n) * dld + k0 + 8 * c) = o; }
    LDS_WAIT(); asm volatile("" ::: "memory");
}

__device__ __forceinline__ int opq_s(int x) { asm volatile("" : "+s"(x)); return x; }
struct MkArgs {
    const float* in[27]; float* out; unsigned char* ws;
    int layer_lo, layer_hi, ph_lo, ph_hi, bar_region, pad;
    float lam_init[4];
    int rep[12];
    ConvArgs conv;
};
constexpr int NPH = 11;
__device__ __forceinline__ void fox_bias_scan(LAS float* cb, LAS float* wtot, const float* logf_row, int n) {
    int tid = threadIdx.x; asm volatile("" : "+v"(tid)); const int lane = tid & 63, wave = __builtin_amdgcn_readfirstlane(tid >> 6);
    float z_ = 0.f; asm volatile("" : "+v"(z_)); f32x4 v = (f32x4){z_, z_, z_, z_}; if (4 * tid < n) v = *(const f32x4*)(logf_row + 4 * tid);
    v.y += v.x; v.z += v.y; v.w += v.z;
    const float tot = v.w; float incl = tot;
#pragma unroll
    for (int o = 1; o < 64; o <<= 1) { const float nb = __shfl_up(incl, o); if (lane >= o) incl += nb; }
    if (lane == 63) wtot[wave] = incl;
    __syncthreads();
    float base = incl - tot;
#pragma unroll
    for (int w = 0; w < 8; ++w) if (w < wave) base += wtot[w];
    if (4 * tid < n) *(LAS f32x4*)(cb + 4 * tid) = (v + base) * (-LOG2E);
    __syncthreads();
}


__device__ __forceinline__ void fgate_stage(LAS float* Wf, const float* w_in_l, int tid) {
    for (int i = tid; i < 1024 * 2; i += NWAVES * 64) *(LAS f32x4*)(Wf + 4 * i) = *(const f32x4*)(w_in_l + (size_t)(i >> 1) * D_IN + C_FF + 4 * (i & 1));
}
__device__ __forceinline__ void fgate_row(const LAS float* rowb, const LAS float* Wf, const float* fbias, float* logf, int t, int lane) {
    float acc[8];
#pragma unroll
    for (int h = 0; h < 8; ++h) acc[h] = 0.f;
#pragma unroll 4
    for (int i = 0; i < 16; ++i) { const int k = lane + 64 * i; const float xs = rowb[k]; const f32x4 w0 = *(const LAS f32x4*)(Wf + k * 8), w1 = *(const LAS f32x4*)(Wf + k * 8 + 4);
        acc[0] += xs * w0.x; acc[1] += xs * w0.y; acc[2] += xs * w0.z; acc[3] += xs * w0.w; acc[4] += xs * w1.x; acc[5] += xs * w1.y; acc[6] += xs * w1.z; acc[7] += xs * w1.w; }
    const int b = t / SEQ, s = t % SEQ;
#pragma unroll
    for (int h = 0; h < 8; ++h) { const float z = wave_sum(acc[h]) + fbias[h]; const float ls = fminf(z, 0.f) - log1pf(__expf(-fabsf(z)));
        if (lane == h) logf[((size_t)(b * 8 + h)) * SEQ + s] = ls; }
}
typedef float f32x16_t __attribute__((ext_vector_type(16)));
typedef short bf16x8_t __attribute__((ext_vector_type(8)));
__device__ __forceinline__ void ssm_setup_group(int g, const float* lam_re, const float* lam_im, const float* log_dt, const float* b_re, const float* b_im, const float* c_re, const float* c_im, const float* dsk,
                                                bf16* MT, bf16* W2, bf16* W3, float* AL, LAS unsigned char* lds) {
    int tid = threadIdx.x; asm volatile("" : "+v"(tid));
    LAS float* apr = (LAS float*)lds;
    LAS float* api = apr + 17 * 64;
    LAS float* bbr = api + 17 * 64;
    LAS float* bbi = bbr + 1024;
    LAS float* ccr = bbi + 1024;
    LAS float* cci = ccr + 1024;
    LAS float* Kt = cci + 1024;
    const float dt = expf(log_dt[g]);
    for (int i = tid; i < 17 * 64; i += NWAVES * 64) { const int tau = i >> 6, p = i & 63; const float lr = lam_re[g * 64 + p], li = lam_im[g * 64 + p];
        const float mag = expf(lr * dt * (float)tau), ang = li * dt * (float)tau; apr[i] = mag * cosf(ang); api[i] = mag * sinf(ang); }
    for (int i = tid; i < 1024; i += NWAVES * 64) { const int p = i >> 4;
        const float lr = lam_re[g * 64 + p], li = lam_im[g * 64 + p]; const float mag = expf(lr * dt), ang = li * dt, ar = mag * cosf(ang), ai = mag * sinf(ang);
        const float er = ar - 1.f, ei = ai, den = lr * lr + li * li, qr = (er * lr + ei * li) / den, qi = (ei * lr - er * li) / den;
        const float br = b_re[(size_t)g * 1024 + i], bi = b_im[(size_t)g * 1024 + i]; bbr[i] = qr * br - qi * bi; bbi[i] = qr * bi + qi * br;
        ccr[i] = c_re[(size_t)g * 1024 + i]; cci[i] = c_im[(size_t)g * 1024 + i]; }
    __syncthreads();
    { const int tau = tid >> 5, m = (tid >> 1) & 15, n0 = (tid & 1) * 8; float acc[8];
#pragma unroll
      for (int n = 0; n < 8; ++n) acc[n] = 0.f;
      for (int p = 0; p < 64; ++p) { const float ar = apr[tau * 64 + p], ai = api[tau * 64 + p], br = bbr[p * 16 + m], bi = bbi[p * 16 + m]; const float tr = ar * br - ai * bi, ti = ar * bi + ai * br;
#pragma unroll
          for (int n = 0; n < 8; ++n) acc[n] += ccr[(n0 + n) * 64 + p] * tr - cci[(n0 + n) * 64 + p] * ti; }
#pragma unroll
      for (int n = 0; n < 8; ++n) Kt[(tau * 16 + n0 + n) * 16 + m] = acc[n] + ((tau == 0 && n0 + n == m) ? dsk[g * 16 + m] : 0.f); }
    __syncthreads();
    for (int v = tid; v < 256 * 32; v += NWAVES * 64) { const int row = v >> 5, c8 = (v & 31) * 8, i = row >> 4, n = row & 15, j = c8 >> 4, m0 = c8 & 15; float k[8];
#pragma unroll
        for (int e = 0; e < 8; ++e) k[e] = (j <= i) ? Kt[((i - j) * 16 + n) * 16 + m0 + e] : 0.f;
        v4u o; o.x = pk2(k[0], k[1]); o.y = pk2(k[2], k[3]); o.z = pk2(k[4], k[5]); o.w = pk2(k[6], k[7]);
        *(v4u*)(MT + (size_t)g * 65536 + row * 256 + c8) = o; }
    for (int v = tid; v < 128 * 32; v += NWAVES * 64) { const int q = v >> 5, c8 = (v & 31) * 8, j = c8 >> 4, m0 = c8 & 15, p = q & 63; const float ar = apr[(15 - j) * 64 + p], ai = api[(15 - j) * 64 + p]; float k[8];
#pragma unroll
        for (int e = 0; e < 8; ++e) { const float br = bbr[p * 16 + m0 + e], bi = bbi[p * 16 + m0 + e]; k[e] = q < 64 ? ar * br - ai * bi : ar * bi + ai * br; }
        v4u o; o.x = pk2(k[0], k[1]); o.y = pk2(k[2], k[3]); o.z = pk2(k[4], k[5]); o.w = pk2(k[6], k[7]);
        *(v4u*)(W2 + (size_t)g * 32768 + q * 256 + c8) = o; }
    for (int v = tid; v < 256 * 16; v += NWAVES * 64) { const int row = v >> 4, c8 = (v & 15) * 8, i = row >> 4, n = row & 15; float k[8];
#pragma unroll
        for (int e = 0; e < 8; ++e) { const int q = c8 + e, p = q & 63; const float ar = apr[(i + 1) * 64 + p], ai = api[(i + 1) * 64 + p], cr = ccr[n * 64 + p], ci = cci[n * 64 + p]; k[e] = q < 64 ? cr * ar - ci * ai : -(cr * ai + ci * ar); }
        v4u o; o.x = pk2(k[0], k[1]); o.y = pk2(k[2], k[3]); o.z = pk2(k[4], k[5]); o.w = pk2(k[6], k[7]);
        *(v4u*)(W3 + (size_t)g * 32768 + row * 128 + c8) = o; }
    if (tid < 64) { AL[g * 128 + tid] = apr[16 * 64 + tid]; AL[g * 128 + 64 + tid] = api[16 * 64 + tid]; }
    __syncthreads();
}
constexpr int SSM_RS = 528;
__device__ __forceinline__ void ssm_unit(int b, int g, const bf16* PROJ, const bf16* MT, const bf16* W2, const bf16* W3, const float* AL, bf16* GY, LAS unsigned char* lds) {
    int tid = threadIdx.x; asm volatile("" : "+v"(tid)); const int lane = tid & 63, wave = __builtin_amdgcn_readfirstlane(tid >> 6), r32 = lane & 31, hi = lane >> 5;
    LAS unsigned char* A1 = lds;
    LAS unsigned char* EB = lds + 128 * SSM_RS;
    { const bf16* up = PROJ + (size_t)b * SEQ * PP + g * 16;
#pragma unroll
      for (int k = 0; k < 8; ++k) { const int pc = tid + 512 * k, t = pc >> 1, hf = pc & 1; const v4u v = *(const v4u*)(up + (size_t)t * PP + hf * 8);
          *(LAS v4u*)(A1 + (t >> 4) * SSM_RS + ((t & 15) * 16 + hf * 8) * 2) = v; } }
    __syncthreads();
    { const int nt = wave & 3, mt0 = (wave >> 2) * 2; f32x16_t acc0, acc1;
#pragma unroll
      for (int r = 0; r < 16; ++r) { acc0[r] = 0.f; acc1[r] = 0.f; }
      const bf16* wp = W2 + (size_t)g * 32768 + (32 * nt + r32) * 256 + 8 * hi;
      const LAS unsigned char* ap = A1 + (32 * mt0 + r32) * SSM_RS + 16 * hi;
#pragma unroll
      for (int ks = 0; ks < 16; ++ks) { const bf16x8_t bf = *(const bf16x8_t*)(wp + 16 * ks);
          const bf16x8_t a0 = *(const LAS bf16x8_t*)(ap + 32 * ks), a1 = *(const LAS bf16x8_t*)(ap + 32 * SSM_RS + 32 * ks);
          acc0 = __builtin_amdgcn_mfma_f32_32x32x16_bf16(a0, bf, acc0, 0, 0, 0); acc1 = __builtin_amdgcn_mfma_f32_32x32x16_bf16(a1, bf, acc1, 0, 0, 0); }
#pragma unroll
      for (int r = 0; r < 16; ++r) { const int cr = (r & 3) + 8 * (r >> 2) + 4 * hi;
          *(LAS float*)(EB + (32 * mt0 + cr) * SSM_RS + (32 * nt + r32) * 4) = acc0[r]; *(LAS float*)(EB + (32 * mt0 + 32 + cr) * SSM_RS + (32 * nt + r32) * 4) = acc1[r]; } }
    __syncthreads();
    if (wave == 0) { const float alr = AL[g * 128 + lane], ali = AL[g * 128 + 64 + lane]; float sr = 0.f, si = 0.f;
        float er = *(const LAS float*)(EB + lane * 4), ei = *(const LAS float*)(EB + 256 + lane * 4);
        for (int c = 0; c < 128; ++c) { const int cn = c < 127 ? c + 1 : c;
            const float ern = *(const LAS float*)(EB + cn * SSM_RS + lane * 4), ein = *(const LAS float*)(EB + cn * SSM_RS + 256 + lane * 4);
            asm volatile("" ::: "memory");
            *(LAS unsigned short*)(EB + c * SSM_RS + lane * 2) = (unsigned short)f2bf(sr); *(LAS unsigned short*)(EB + c * SSM_RS + 128 + lane * 2) = (unsigned short)f2bf(si);
            const float nr = alr * sr - ali * si + er, ni = alr * si + ali * sr + ei; sr = nr; si = ni; er = ern; ei = ein; } }
    __syncthreads();
    { f32x16_t acc[4];
#pragma unroll
      for (int m = 0; m < 4; ++m)
#pragma unroll
          for (int r = 0; r < 16; ++r) acc[m][r] = 0.f;
      const bf16* mp = MT + (size_t)g * 65536 + (32 * wave + r32) * 256 + 8 * hi; const bf16* w3p = W3 + (size_t)g * 32768 + (32 * wave + r32) * 128 + 8 * hi;
      const LAS unsigned char* ap = A1 + r32 * SSM_RS + 16 * hi; const LAS unsigned char* sp = EB + r32 * SSM_RS + 16 * hi;
#pragma unroll
      for (int ks = 0; ks < 16; ++ks) { const bf16x8_t bf = *(const bf16x8_t*)(mp + 16 * ks);
#pragma unroll
          for (int m = 0; m < 4; ++m) { const bf16x8_t af = *(const LAS bf16x8_t*)(ap + 32 * m * SSM_RS + 32 * ks); acc[m] = __builtin_amdgcn_mfma_f32_32x32x16_bf16(af, bf, acc[m], 0, 0, 0); } }
#pragma unroll
      for (int ks = 0; ks < 8; ++ks) { const bf16x8_t bf = *(const bf16x8_t*)(w3p + 16 * ks);
#pragma unroll
          for (int m = 0; m < 4; ++m) { const bf16x8_t af = *(const LAS bf16x8_t*)(sp + 32 * m * SSM_RS + 32 * ks); acc[m] = __builtin_amdgcn_mfma_f32_32x32x16_bf16(af, bf, acc[m], 0, 0, 0); } }
      const int i = 2 * wave + (r32 >> 4), n = r32 & 15; bf16* gp = GY + ((size_t)b * SEQ + i) * 512 + g * 16 + n;
#pragma unroll
      for (int m = 0; m < 4; ++m)
#pragma unroll
          for (int r = 0; r < 16; ++r) { const int c = 32 * m + (r & 3) + 8 * (r >> 2) + 4 * hi; const float y = acc[m][r]; const float u2 = 1.5957691216057308f * (y + 0.044715f * y * y * y);
              gp[(size_t)c * 16 * 512] = (bf16)f2bf(y * pg8::sigm(u2)); } }
    __syncthreads();
}
__global__ void __launch_bounds__(NWAVES * 64, 2) mk_kernel(MkArgs a) {
    extern __shared__ __attribute__((aligned(16))) unsigned char lds_raw[];
    LAS unsigned char* lds = (LAS unsigned char*)lds_raw;
    volatile LAS unsigned* MISC = (volatile LAS unsigned*)(lds + MISC_OFF);
    const int G = gridDim.x; const int vcu = (G % 8 == 0) ? ((int)blockIdx.x % 8) * (G / 8) + (int)blockIdx.x / 8 : (int)blockIdx.x;
    unsigned char* ws = a.ws;
    for (int u = threadIdx.x; u < (LDS_BYTES - MISC_OFF) / 4; u += NWAVES * 64) MISC[u] = 0u;
    __syncthreads();
    XcdBarrier bar = xcd_barrier_post((unsigned*)(ws + WS_CTL) + CW_BAR + a.bar_region * XCD_BAR_WORDS, MISC + 8);
#define PHASE_PTRS() const CAS MkArgs* akp = (const CAS MkArgs*)__builtin_amdgcn_kernarg_segment_ptr(); asm volatile("" : "+s"(akp)); const CAS MkArgs& ak = *akp;   unsigned char* wsp = ak.ws; const int Gp = opq_s((int)gridDim.x), bxp = opq_s((int)blockIdx.x); const int vcup = (Gp % 8 == 0) ? (bxp % 8) * (Gp / 8) + bxp / 8 : bxp; (void)vcup;   \
    bf16* BR = (bf16*)(wsp + WS_BR); bf16* OD = (bf16*)(wsp + WS_OD); const float* LOGF = (const float*)(wsp + WS_LOGF); \
    bf16* GY = (bf16*)(wsp + WS_GY); bf16* WGLU = (bf16*)(wsp + WS_WGLU); bf16* WB = (bf16*)(wsp + WS_WB); bf16* WO = (bf16*)(wsp + WS_WO); bf16* P = (bf16*)(wsp + WS_P); bf16* MG = (bf16*)(wsp + WS_MG); \
    float* MIX = (float*)(wsp + WS_MIX); float* GATE = (float*)(wsp + WS_ROUTE); \
    int* TOKL = (int*)(wsp + WS_TOKL); float* WL = (float*)(wsp + WS_WL); int* TSLOT = (int*)(wsp + WS_TSLOT); bf16* HB = (bf16*)(wsp + WS_H); bf16* YB = (bf16*)(wsp + WS_Y); \
    bf16* WGU = (bf16*)(wsp + WS_WG); bf16* WD = (bf16*)(wsp + WS_WD); bf16* SMT = (bf16*)(wsp + WS_SMT); bf16* SW2 = (bf16*)(wsp + WS_SW2); bf16* SW3 = (bf16*)(wsp + WS_SW3); float* SAL = (float*)(wsp + WS_SAL); (void)SMT; (void)SW2; (void)SW3; (void)SAL; \
    bf16* WIN = (bf16*)(wsp + WS_WIN); bf16* XB = (bf16*)(wsp + WS_XB); bf16* PROJ = (bf16*)(wsp + WS_PROJ); bf16* GL = (bf16*)(wsp + WS_GL); const float* ROPE = (const float*)(wsp + WS_ROPE); \
    (void)BR; (void)OD; (void)LOGF; (void)GY; (void)WGLU; (void)WB; (void)WO; (void)P; (void)MG; (void)MIX; (void)GATE; (void)TOKL; (void)WL; (void)TSLOT; (void)HB; (void)YB; (void)WGU; (void)WD; (void)WIN; (void)XB; (void)PROJ; (void)GL; (void)ROPE
    LAS int* TBL = (LAS int*)(lds + MISC_OFF + 64);
#define MOE_TABLES() do { if (threadIdx.x == 0) { int acc_ = 0; _Pragma("unroll 1") for (int e_ = 0; e_ < 16; ++e_) { const int n_ = (int)__hip_atomic_load((unsigned*)(wsp + WS_CTL) + CW_CNT + 1024 * layer + 64 * e_, RLX_AGENT); TBL[e_] = acc_; TBL[32 + e_] = n_; \
        const int nt_ = (n_ + 255) >> 8; _Pragma("unroll 1") for (int r_ = 0; r_ < nt_; ++r_) TBL[64 + acc_ + r_] = e_; acc_ += nt_; } TBL[16] = acc_; } __syncthreads(); } while (0)
    const int ph_lo = a.ph_lo, ph_hi = a.ph_hi;
#define IN(k) (opq_s(ph_lo) <= (k) && (k) < opq_s(ph_hi))
#ifdef PROBE_BAR2
#define SEAM(k) do { if ((k) == 9) break; if (IN((k) + 1) || ((k) + 1 == NPH && ph_lo == 0 && layer + 1 < a.layer_hi)) { xcd_barrier(bar); xcd_barrier(bar); } } while (0)
#else
#define SEAM(k) do { if ((k) == 9) break; if (IN((k) + 1) || ((k) + 1 == NPH && ph_lo == 0 && layer + 1 < a.layer_hi)) xcd_barrier(bar); } while (0)
#endif
    for (int layer = a.layer_lo; layer < a.layer_hi; ++layer) {
        if (IN(0)) { for (int rr_ = 0; rr_ < a.rep[0]; ++rr_) {
            PHASE_PTRS();
            int tid = threadIdx.x; asm volatile("" : "+v"(tid)); const int lane = tid & 63, wave = __builtin_amdgcn_readfirstlane(tid >> 6);
            const int gw = vcup * NWAVES + wave, NGW = Gp * NWAVES;
            if (layer == 0) {
                float* tab = (float*)(wsp + WS_ROPE);
                for (int idx = gw * 64 + lane; idx < SEQ * 32; idx += NGW * 64) { const int s = idx >> 5, i = idx & 31;
                    const float inv_freq = exp2f(-(float)(2 * i) * (13.287712379549449f / 64.0f)); const float ang = (float)s * inv_freq;
                    const double rev = (double)ang * 0.15915494309189535; const double fr = rev - __builtin_floor(rev + 0.5); const float an = (float)(fr * 6.283185307179586);
                    tab[idx] = cosf(an); tab[SEQ * 32 + idx] = sinf(an); }
                const float* x_in = ak.in[0];
                LAS float* Wf = (LAS float*)lds; LAS float* rowb = (LAS float*)(lds + 32768 + wave * 4096);
                fgate_stage(Wf, ak.in[1], tid);
                __syncthreads();
                for (int t = gw; t < M_TOK; t += NGW) {
#pragma unroll
                    for (int j = 0; j < 4; ++j) { const int c = 4 * lane + 256 * j; const f32x4 v = *(const f32x4*)(x_in + (size_t)t * DM + c); *(LAS f32x4*)(rowb + c) = v;
                        uint2 w; w.x = pk2(v.x, v.y); w.y = pk2(v.z, v.w); *(uint2*)(XB + (size_t)t * DM + c) = w; }
                    LDS_WAIT(); asm volatile("" ::: "memory");
                    fgate_row(rowb, Wf, ak.in[15], (float*)(wsp + WS_LOGF), t, lane);
                    asm volatile("" ::: "memory"); }
                __syncthreads();
            }
            LAS float* scr = (LAS float*)(lds + wave * 16384);
            for (int it = gw + (layer == 0 ? 0 : ak.conv.nitemsA); it < ak.conv.nitems; it += NGW) conv_item(ak.conv, layer, it, scr, lane);
            __syncthreads();
            if (layer == 0) for (int g = vcup; g < 32; g += Gp)
                ssm_setup_group(g, ak.in[4] + layer * 2048, ak.in[5] + layer * 2048, ak.in[6] + layer * 32, ak.in[7] + (size_t)layer * 32768, ak.in[8] + (size_t)layer * 32768, ak.in[9] + (size_t)layer * 32768, ak.in[10] + (size_t)layer * 32768,
                                ak.in[11] + layer * 512, SMT, SW2, SW3, SAL, lds);
            } SEAM(0);
        }
        if (IN(1)) { for (int rr_ = 0; rr_ < a.rep[1]; ++rr_) {
            PHASE_PTRS();
            const bf16* Ap = XB; const bf16* Bp = WIN; asm volatile("" : "+s"(Ap), "+s"(Bp));
            pg8::Gemm g; g.A = Ap; g.Bt = Bp; g.zA = 0; g.zB = 0; g.M = M_TOK; g.N = 6656; g.K = DM; g.lda = DM; g.ldb = DM; g.pad = 0;
            pg8::StaticOrder S; S.init(M_TOK, 6656, Gp, bxp);
            pg8::EpiInProj E{PROJ, GL, ROPE, C2, 0};
            pg8::gemm_phase<pg8::EpiInProj, pg8::StaticOrder, true, true>(lds, g, S, E);
            } SEAM(1);
        }
        if (IN(2)) { for (int rr_ = 0; rr_ < a.rep[2]; ++rr_) {
            PHASE_PTRS();
            for (int u = vcup; u < 256; u += Gp) ssm_unit(u >> 5, u & 31, PROJ, SMT, SW2, SW3, SAL, GY, lds);
            char* shm = (char*)lds_raw;
            const attn_body::bf16* PJ = (const attn_body::bf16*)PROJ;
            for (int pi = vcup; pi < 256; pi += Gp) {
                const int row = pi >> 2, sq = pi & 3, b = row >> 3, h = row & 7;
                for (int k = 0; k < 2; ++k) { const int qb = k ? sq : 7 - sq;
                    fox_bias_scan((LAS float*)(lds + attn_body::LDS_BIAS), (LAS float*)(lds + attn_body::LDS_WS), LOGF + (size_t)(b * 8 + h) * SEQ, (qb + 1) * 256);
                    attn_body::attn_unit<8, true, 512>(b, qb, PJ + 2048 + h * 64, PJ + 2560 + h * 64, PJ + 3072 + h * 64, (attn_body::bf16*)(BR + (size_t)2 * M_TOK * 512) + h * 64, shm); }
            }
            for (int pi = 256 + vcup; pi < 768; pi += Gp) {
                const int row = (pi >> 2) - 64, sq = pi & 3, b = row >> 4, hc = (row >> 1) & 7, vh = row & 1;
                for (int k = 0; k < 2; ++k) { const int qb = k ? sq : 7 - sq;
                    attn_body::attn_unit<8, false, 1024>(b, qb, PJ + 512 + hc * 64, PJ + 1024 + hc * 64, PJ + 1536 + (hc >> 1) * 128 + vh * 64, (attn_body::bf16*)OD + (hc & 1) * 512 + (hc >> 1) * 128 + vh * 64, shm); }
            }
            } SEAM(2);
        }
        if (IN(3)) { for (int rr_ = 0; rr_ < a.rep[3]; ++rr_) {
            PHASE_PTRS();
            {   const bf16* Ap = GY; const bf16* Bp = WGLU; asm volatile("" : "+s"(Ap), "+s"(Bp));
                pg8::Gemm g; g.A = Ap; g.Bt = Bp; g.zA = 0; g.zB = 0; g.M = M_TOK; g.N = 1024; g.K = 512; g.lda = 512; g.ldb = 512; g.pad = 0;
                pg8::StaticOrder S; S.init(M_TOK, 1024, Gp, bxp);
                pg8::EpiGlu E{BR, 512, 0};
                pg8::gemm_phase<pg8::EpiGlu, pg8::StaticOrder, true, true>(lds, g, S, E); }
            {   int tid = threadIdx.x; asm volatile("" : "+v"(tid)); const int lane = tid & 63, wave = __builtin_amdgcn_readfirstlane(tid >> 6);
                const float* lam = ak.in[13] + layer * 256; const float* gnorm = ak.in[14] + layer * 512; const float lam_init = ak.lam_init[layer];
                const float s01 = wave_sum(lam[lane] * lam[64 + lane]), s23 = wave_sum(lam[128 + lane] * lam[192 + lane]);
                const float lam_full = expf(s01) - expf(s23) + lam_init;
                bf16* YD = BR + (size_t)M_TOK * 512;
                const int hh = lane >> 4, d8 = (lane & 15) * 8; const float sc = 1.f - lam_init;
                float gn[8];
#pragma unroll
                for (int e = 0; e < 8; ++e) gn[e] = gnorm[hh * 128 + d8 + e] * sc;
                const int tstr = Gp * NWAVES, tfirst = vcup * NWAVES + wave;
                v4u n0, n1; { const int tc = tfirst < M_TOK ? tfirst : 0; n0 = *(const v4u*)(OD + (size_t)tc * 1024 + hh * 128 + d8); n1 = *(const v4u*)(OD + (size_t)tc * 1024 + 512 + hh * 128 + d8); }
                for (int t = tfirst; t < M_TOK; t += tstr) {
                    const v4u c0 = n0, c1 = n1; const int tn = t + tstr;
                    if (tn < M_TOK) { n0 = *(const v4u*)(OD + (size_t)tn * 1024 + hh * 128 + d8); n1 = *(const v4u*)(OD + (size_t)tn * 1024 + 512 + hh * 128 + d8); }
                    const unsigned w0[4] = {c0.x, c0.y, c0.z, c0.w}, w1[4] = {c1.x, c1.y, c1.z, c1.w}; float av[8]; float ss = 0.f;
#pragma unroll
                    for (int e = 0; e < 4; ++e) { av[2 * e] = __builtin_bit_cast(float, w0[e] << 16) - lam_full * __builtin_bit_cast(float, w1[e] << 16); av[2 * e + 1] = __builtin_bit_cast(float, w0[e] & 0xffff0000u) - lam_full * __builtin_bit_cast(float, w1[e] & 0xffff0000u);
                        ss += av[2 * e] * av[2 * e] + av[2 * e + 1] * av[2 * e + 1]; }
#define R16_DPP(ctrl) ss += __builtin_bit_cast(float, __builtin_amdgcn_update_dpp(0, __builtin_bit_cast(int, ss), ctrl, 0xf, 0xf, true))
                    R16_DPP(0xB1); R16_DPP(0x4E); R16_DPP(0x141); R16_DPP(0x140);
#undef R16_DPP
                    const float r = rsqrtf(ss * (1.f / 128.f) + RMS_EPS);
                    v4u o; o.x = pk2(av[0] * r * gn[0], av[1] * r * gn[1]); o.y = pk2(av[2] * r * gn[2], av[3] * r * gn[3]); o.z = pk2(av[4] * r * gn[4], av[5] * r * gn[5]); o.w = pk2(av[6] * r * gn[6], av[7] * r * gn[7]);
                    *(v4u*)(YD + (size_t)t * 512 + hh * 128 + d8) = o; } }
            } SEAM(3);
        }
        if (IN(4)) { for (int rr_ = 0; rr_ < a.rep[4]; ++rr_) {
            PHASE_PTRS();
            const bf16* Ap = BR; const bf16* Bp = WB; asm volatile("" : "+s"(Ap), "+s"(Bp));
            pg8::Gemm g; g.A = Ap; g.Bt = Bp; g.zA = (long)M_TOK * 512 * 2; g.zB = 1024L * 512 * 2; g.M = M_TOK; g.N = 1024; g.K = 512; g.lda = 512; g.ldb = 512; g.pad = 0;
            pg8::BatchOrder S; S.init(M_TOK, 1024, 3, Gp, bxp);
            pg8::EpiGatedChain E{MG, GL};
            pg8::gemm_phase<pg8::EpiGatedChain, pg8::BatchOrder, true, true>(lds, g, S, E);
            } SEAM(4);
        }
        if (IN(6)) { for (int rr_ = 0; rr_ < a.rep[6]; ++rr_) {
            PHASE_PTRS();
            const bf16* Ap = MG; const bf16* Bp = WO; asm volatile("" : "+s"(Ap), "+s"(Bp));
            pg8::Gemm g; g.A = Ap; g.Bt = Bp; g.zA = 0; g.zB = 0; g.M = M_TOK; g.N = DM; g.K = DM; g.lda = DM; g.ldb = DM; g.pad = 0;
            pg8::StaticOrder S; S.init(M_TOK, DM, Gp, bxp);
            pg8::EpiStoreF32 E{MIX, DM, 0};
            pg8::gemm_phase<pg8::EpiStoreF32, pg8::StaticOrder, true, true>(lds, g, S, E);
            } SEAM(6);
        }
        if (IN(7)) { for (int rr_ = 0; rr_ < a.rep[7]; ++rr_) {
            PHASE_PTRS();
            int tid = threadIdx.x; asm volatile("" : "+v"(tid)); const int lane = tid & 63, wave = __builtin_amdgcn_readfirstlane(tid >> 6);
            const bool fake = rr_ + 1 < a.rep[7];
            float* outp = fake ? (float*)(wsp + WS_PROJ) : ak.out; bf16* XBp = fake ? (bf16*)(wsp + WS_PROJ + 64 * MiB) : XB; int* TOKLp = fake ? (int*)(wsp + WS_OD) : TOKL; float* WLp = fake ? (float*)(wsp + WS_OD + 2 * MiB) : WL; int* TSLOTp = fake ? (int*)(wsp + WS_OD + 4 * MiB) : TSLOT; const int cl = fake ? 4 + layer : layer;
            const float* xin = layer == 0 ? ak.in[0] : ak.out;
            const float* w_g = ak.in[18] + (size_t)layer * DM * 4; const float* w_e = ak.in[20] + (size_t)layer * DM * 16;
            LAS float* Wl = (LAS float*)lds;
            LAS float* rowb = (LAS float*)(lds + 81920 + wave * 4096);
            LAS int* lcnt = (LAS int*)(lds + 81920 + 8 * 4096);
            LAS int* rec = lcnt + 32;
            if (tid < 32) lcnt[tid] = 0;
            int nrow = 0;
            for (int i = tid; i < 1024 * 4; i += NWAVES * 64) Wl[(i >> 2) * 20 + (i & 3)] = w_g[i];
            for (int i = tid; i < 1024 * 16; i += NWAVES * 64) Wl[(i >> 4) * 20 + 4 + (i & 15)] = w_e[i];
            __syncthreads();
            const float* lg_ = ak.in[16] + layer * DM; const float* lb_ = ak.in[17] + layer * DM; const float* b_g = ak.in[19] + layer * 4; const float* b_e = ak.in[21] + layer * 16;
            f32x4 nx[4], nm[4];
            { const int t0 = vcup * NWAVES + wave;
#pragma unroll
              for (int j = 0; j < 4; ++j) { const size_t o = (size_t)(t0 < M_TOK ? t0 : 0) * DM + 4 * lane + 256 * j; nx[j] = *(const f32x4*)(xin + o); nm[j] = *(const f32x4*)(MIX + o); } }
            for (int t = vcup * NWAVES + wave; t < M_TOK; t += Gp * NWAVES) {
                f32x4 v[4]; float s = 0.f;
#pragma unroll
                for (int j = 0; j < 4; ++j) { v[j] = ALPHA * nx[j] + nm[j]; s += (v[j].x + v[j].y) + (v[j].z + v[j].w); }
                { const int tn = t + Gp * NWAVES;
                  if (tn < M_TOK) {
#pragma unroll
                      for (int j = 0; j < 4; ++j) { const size_t o = (size_t)tn * DM + 4 * lane + 256 * j; nx[j] = *(const f32x4*)(xin + o); nm[j] = *(const f32x4*)(MIX + o); } } }
                const float mean = wave_sum(s) * (1.f / DM); float s2 = 0.f;
#pragma unroll
                for (int j = 0; j < 4; ++j) { v[j] = v[j] - mean; s2 += (v[j].x * v[j].x + v[j].y * v[j].y) + (v[j].z * v[j].z + v[j].w * v[j].w); }
                const float rstd = rsqrtf(wave_sum(s2) * (1.f / DM) + LN_EPS);
#pragma unroll
                for (int j = 0; j < 4; ++j) { const int c = 4 * lane + 256 * j; const size_t o = (size_t)t * DM + c; v[j] = v[j] * rstd * *(const f32x4*)(lg_ + c) + *(const f32x4*)(lb_ + c);
                    *(f32x4*)(outp + o) = v[j]; uint2 w; w.x = pk2(v[j].x, v[j].y); w.y = pk2(v[j].z, v[j].w); *(uint2*)(XBp + o) = w; *(LAS f32x4*)(rowb + c) = v[j]; }
                LDS_WAIT(); asm volatile("" ::: "memory");
                float lg[20];
#pragma unroll
                for (int q = 0; q < 20; ++q) lg[q] = 0.f;
#pragma unroll 2
                for (int i = 0; i < 16; ++i) { const int k = lane + 64 * i; const float xs = rowb[k]; const LAS f32x4* wp = (const LAS f32x4*)(Wl + k * 20);
#pragma unroll
                    for (int q = 0; q < 5; ++q) { const f32x4 w = wp[q]; lg[4 * q] += xs * w.x; lg[4 * q + 1] += xs * w.y; lg[4 * q + 2] += xs * w.z; lg[4 * q + 3] += xs * w.w; } }
#pragma unroll
                for (int q = 0; q < 20; ++q) lg[q] = wave_sum(lg[q]) + (q < 4 ? b_g[q] : b_e[q - 4]);
                int gi = 0; float gm = lg[0];
#pragma unroll
                for (int q = 1; q < 4; ++q) if (lg[q] > gm) { gm = lg[q]; gi = q; }
                float den = 0.f;
#pragma unroll
                for (int q = 0; q < 4; ++q) den += __expf(lg[q] - gm);
                const float gp = 1.f / den;
                float sel[4];
#pragma unroll
                for (int q = 0; q < 4; ++q) sel[q] = gi == 0 ? lg[4 + q] : gi == 1 ? lg[8 + q] : gi == 2 ? lg[12 + q] : lg[16 + q];
                int i0 = 0; float v0 = sel[0];
#pragma unroll
                for (int q = 1; q < 4; ++q) if (sel[q] > v0) { v0 = sel[q]; i0 = q; }
                int i1 = -1; float v1 = -INFINITY;
#pragma unroll
                for (int q = 0; q < 4; ++q) if (q != i0 && sel[q] > v1) { v1 = sel[q]; i1 = q; }
                const float e1 = __expf(v1 - v0), w0 = gp / (1.f + e1), w1 = gp * e1 / (1.f + e1);
                const int E0 = gi * 4 + i0, E1 = gi * 4 + i1;
                if (lane < 16) GATE[(size_t)t * 16 + lane] = (lane == E0 ? w0 : 0.f) + (lane == E1 ? w1 : 0.f);
                if (lane == 0) {
                    const int r0 = (int)__hip_atomic_fetch_add((LAS unsigned*)lcnt + E0, 1u, __ATOMIC_RELAXED, __HIP_MEMORY_SCOPE_WORKGROUP), r1 = (int)__hip_atomic_fetch_add((LAS unsigned*)lcnt + E1, 1u, __ATOMIC_RELAXED, __HIP_MEMORY_SCOPE_WORKGROUP);
                    LAS int* rc = rec + (wave * 16 + nrow) * 8; rc[0] = t; rc[1] = E0; rc[2] = E1; rc[3] = r0; rc[4] = r1; rc[5] = __float_as_int(w0); rc[6] = __float_as_int(w1); }
                ++nrow;
                asm volatile("" ::: "memory");
            }
            __syncthreads();
            if (tid < 16) { const int n = lcnt[tid]; lcnt[16 + tid] = n ? (int)__hip_atomic_fetch_add((unsigned*)(wsp + WS_CTL) + CW_CNT + 1024 * cl + 64 * tid, (unsigned)n, RLX_AGENT) : 0; }
            __syncthreads();
            if (lane == 0) for (int k = 0; k < nrow; ++k) { const LAS int* rc = rec + (wave * 16 + k) * 8; const int t = rc[0], E0 = rc[1], E1 = rc[2], p0 = lcnt[16 + E0] + rc[3], p1 = lcnt[16 + E1] + rc[4];
                TOKLp[E0 * 16384 + p0] = t; WLp[E0 * 16384 + p0] = __int_as_float(rc[5]); TOKLp[E1 * 16384 + p1] = t; WLp[E1 * 16384 + p1] = __int_as_float(rc[6]);
                TSLOTp[2 * t] = (E0 << 20) | p0; TSLOTp[2 * t + 1] = (E1 << 20) | p1; }
            } SEAM(7);
        }
        if (IN(8)) { for (int rr_ = 0; rr_ < a.rep[8]; ++rr_) {
            PHASE_PTRS();
            MOE_TABLES();
            const int NT = __builtin_amdgcn_readfirstlane(TBL[16]);
            if (vcup < NT) {
                pg8::MoeTables T{TBL, TBL + 32};
                {   const bf16* Ap = XB; const bf16* Bp = WGU; asm volatile("" : "+s"(Ap), "+s"(Bp));
                    pg8::Gemm g; g.A = Ap; g.Bt = Bp; g.zA = 0; g.zB = 512L * 1024 * 2; g.M = 0; g.N = 512; g.K = DM; g.lda = DM; g.ldb = DM; g.pad = 0;
                    pg8::MoeTileOrder<2> S{T, TOKL, vcup, Gp, DM * 2};
                    pg8::EpiMoeUp E{HB, WL, T};
                    pg8::gemm_phase<pg8::EpiMoeUp, pg8::MoeTileOrder<2>, true, true, true>(lds, g, S, E); }
                asm volatile("s_waitcnt vmcnt(0)" ::: "memory");
                if (threadIdx.x == 0) { __builtin_amdgcn_fence(__ATOMIC_ACQUIRE, "agent"); asm volatile("s_waitcnt vmcnt(0)" ::: "memory"); }
                __syncthreads();
                {   const bf16* Ap = HB; const bf16* Bp = WD; asm volatile("" : "+s"(Ap), "+s"(Bp));
                    pg8::Gemm g; g.A = Ap; g.Bt = Bp; g.zA = 0; g.zB = 256 * 2; g.M = 0; g.N = DM; g.K = 256; g.lda = 256; g.ldb = 4096; g.pad = 0;
                    pg8::MoeTileOrder<4> S{T, TOKL, vcup, Gp, 0};
                    pg8::EpiStoreBf16 E{YB, DM, 0, 0};
                    pg8::gemm_phase<pg8::EpiStoreBf16, pg8::MoeTileOrder<4>, true, true>(lds, g, S, E); }
            } else if (layer + 1 < DEPTH && rr_ == 0) {
                int tid = threadIdx.x; asm volatile("" : "+v"(tid)); const int lane = tid & 63, wave = __builtin_amdgcn_readfirstlane(tid >> 6);
                const int idle = vcup - NT, nidle = Gp - NT;
                LAS float* scr = (LAS float*)(lds + wave * 16384);
                for (int it = idle * NWAVES + wave; it < ak.conv.nitemsA; it += nidle * NWAVES) conv_item(ak.conv, layer + 1, it, scr, lane);
                __syncthreads();
                for (int g = idle; g < 32; g += nidle)
                    ssm_setup_group(g, ak.in[4] + (layer + 1) * 2048, ak.in[5] + (layer + 1) * 2048, ak.in[6] + (layer + 1) * 32, ak.in[7] + (size_t)(layer + 1) * 32768, ak.in[8] + (size_t)(layer + 1) * 32768, ak.in[9] + (size_t)(layer + 1) * 32768,
                                    ak.in[10] + (size_t)(layer + 1) * 32768, ak.in[11] + (layer + 1) * 512, SMT, SW2, SW3, SAL, lds);
            }
            } SEAM(8);
        }
        if (IN(10)) { for (int rr_ = 0; rr_ < a.rep[10]; ++rr_) {
            PHASE_PTRS();
            MOE_TABLES();
            int tid = threadIdx.x; asm volatile("" : "+v"(tid)); const int lane = tid & 63, wave = __builtin_amdgcn_readfirstlane(tid >> 6);
            const bool fake = rr_ + 1 < a.rep[10]; float* outp = fake ? (float*)(wsp + WS_GL) : ak.out; bf16* XBp = fake ? (bf16*)(wsp + WS_GL + 64 * MiB) : XB; float* LOGFp = fake ? (float*)(wsp + WS_OD) : (float*)(wsp + WS_LOGF);
            const float* lg_ = ak.in[25] + layer * DM; const float* lb_ = ak.in[26] + layer * DM;
            const bool nextl = layer + 1 < DEPTH;
            LAS float* Wf = (LAS float*)lds; LAS float* rowb = (LAS float*)(lds + 32768 + wave * 4096);
            if (nextl) { fgate_stage(Wf, ak.in[1] + (size_t)(layer + 1) * DM * D_IN, tid); __syncthreads(); }
            const int tstr = Gp * NWAVES, tfirst = vcup * NWAVES + wave;
            uint2 na[4], nb[4]; f32x4 nxr[4];
            int ns0 = 0, ns1 = 0;
            { const int tc = tfirst < M_TOK ? tfirst : 0; const int s0 = TSLOT[2 * tc], s1 = TSLOT[2 * tc + 1];
              const bf16* y0 = YB + (size_t)(TBL[s0 >> 20] * 256 + (s0 & 0xfffff)) * DM; const bf16* y1 = YB + (size_t)(TBL[s1 >> 20] * 256 + (s1 & 0xfffff)) * DM;
#pragma unroll
              for (int j = 0; j < 4; ++j) { const int c = 4 * lane + 256 * j; na[j] = *(const uint2*)(y0 + c); nb[j] = *(const uint2*)(y1 + c); nxr[j] = *(const f32x4*)(ak.out + (size_t)tc * DM + c); }
              const int t1 = tfirst + tstr; if (t1 < M_TOK) { ns0 = TSLOT[2 * t1]; ns1 = TSLOT[2 * t1 + 1]; } }
            for (int t = tfirst; t < M_TOK; t += tstr) {
                f32x4 v[4]; float s = 0.f;
#pragma unroll
                for (int j = 0; j < 4; ++j) { const uint2 p0 = na[j], p1 = nb[j];
                    f32x4 ff; ff.x = __builtin_bit_cast(float, p0.x << 16) + __builtin_bit_cast(float, p1.x << 16); ff.y = __builtin_bit_cast(float, p0.x & 0xffff0000u) + __builtin_bit_cast(float, p1.x & 0xffff0000u);
                    ff.z = __builtin_bit_cast(float, p0.y << 16) + __builtin_bit_cast(float, p1.y << 16); ff.w = __builtin_bit_cast(float, p0.y & 0xffff0000u) + __builtin_bit_cast(float, p1.y & 0xffff0000u);
                    v[j] = ALPHA * nxr[j] + ff; s += (v[j].x + v[j].y) + (v[j].z + v[j].w); }
                { const int tn = t + tstr;
                  if (tn < M_TOK) { const bf16* y0 = YB + (size_t)(TBL[ns0 >> 20] * 256 + (ns0 & 0xfffff)) * DM; const bf16* y1 = YB + (size_t)(TBL[ns1 >> 20] * 256 + (ns1 & 0xfffff)) * DM;
#pragma unroll
                      for (int j = 0; j < 4; ++j) { const int c = 4 * lane + 256 * j; na[j] = *(const uint2*)(y0 + c); nb[j] = *(const uint2*)(y1 + c); nxr[j] = *(const f32x4*)(ak.out + (size_t)tn * DM + c); }
                      const int t2 = tn + tstr; if (t2 < M_TOK) { ns0 = TSLOT[2 * t2]; ns1 = TSLOT[2 * t2 + 1]; } } }
                const float mean = wave_sum(s) * (1.f / DM); float s2 = 0.f;
#pragma unroll
                for (int j = 0; j < 4; ++j) { v[j] = v[j] - mean; s2 += (v[j].x * v[j].x + v[j].y * v[j].y) + (v[j].z * v[j].z + v[j].w * v[j].w); }
                const float rstd = rsqrtf(wave_sum(s2) * (1.f / DM) + LN_EPS);
#pragma unroll
                for (int j = 0; j < 4; ++j) { const int c = 4 * lane + 256 * j; const size_t o = (size_t)t * DM + c; v[j] = v[j] * rstd * *(const f32x4*)(lg_ + c) + *(const f32x4*)(lb_ + c);
                    *(f32x4*)(outp + o) = v[j]; uint2 w; w.x = pk2(v[j].x, v[j].y); w.y = pk2(v[j].z, v[j].w); *(uint2*)(XBp + o) = w; if (nextl) *(LAS f32x4*)(rowb + c) = v[j]; }
                if (nextl) { LDS_WAIT(); asm volatile("" ::: "memory"); fgate_row(rowb, Wf, ak.in[15] + (layer + 1) * 8, LOGFp, t, lane); asm volatile("" ::: "memory"); }
            }
            } SEAM(10);
        }
    }
#undef IN
#undef SEAM
}


template <class Epi> static void launch_gemm(hipStream_t st, int grid, const bf16* A, int lda, const bf16* Bt, int ldb, int M, int N, int K, Epi E) {
    static bool attr = false;
    if (!attr) { (void)hipFuncSetAttribute((const void*)gemm_kernel<Epi>, hipFuncAttributeMaxDynamicSharedMemorySize, pg8::STAGE_BYTES); attr = true; }
    pg8::Gemm g{}; g.A = A; g.Bt = Bt; g.M = M; g.N = N; g.K = K; g.lda = lda; g.ldb = ldb; g.pad = 0; g.zA = 0; g.zB = 0;
    hipLaunchKernelGGL(gemm_kernel<Epi>, dim3(grid), dim3(512), pg8::STAGE_BYTES, st, g, E);
}
static void add_job(ConvArgs& A, const float* src, long lstride, bf16* dst, int K, int N, int ld_src, int col0, int nbatch, long sbs, long dbs, int dst_ld, int mode) {
    ConvJob& J = A.j[A.njobs]; J.src = src; J.dst = dst; J.src_lstride = lstride; J.src_bstride = sbs; J.dst_bstride = dbs; J.K = K; J.N = N; J.ld_src = ld_src; J.col0 = col0; J.nbatch = nbatch; J.dst_ld = dst_ld; J.item0 = A.nitems; J.mode = mode;
    A.nitems += nbatch * (K / 64) * (N / 32); A.njobs++;
}

extern "C" void kernel_launch(void* const* d_in, const int* in_sizes, int n_in, void* d_out, int out_size, void* d_ws, size_t ws_size, hipStream_t stream) {
    if (n_in != 27 || in_sizes[0] != M_TOK * DM || out_size != M_TOK * DM || ws_size < WS_END) { fprintf(stderr, "kernel_launch: unexpected shapes (n_in %d, ws %zu < %zu?)\n", n_in, ws_size, (size_t)WS_END); return; }
    const float* x_in = (const float*)d_in[0]; const float* w_in = (const float*)d_in[1]; const float* w_branch = (const float*)d_in[2]; const float* w_out = (const float*)d_in[3];
    const float* lam_re = (const float*)d_in[4]; const float* lam_im = (const float*)d_in[5]; const float* log_dt = (const float*)d_in[6];
    const float* b_re = (const float*)d_in[7]; const float* b_im = (const float*)d_in[8]; const float* c_re = (const float*)d_in[9]; const float* c_im = (const float*)d_in[10];
    const float* ssm_d = (const float*)d_in[11]; const float* w_glu = (const float*)d_in[12]; const float* diff_lam = (const float*)d_in[13]; const float* diff_g = (const float*)d_in[14];
    const float* fox_b = (const float*)d_in[15]; const float* ln1_g = (const float*)d_in[16]; const float* ln1_b = (const float*)d_in[17];
    const float* mw_g = (const float*)d_in[18]; const float* mb_g = (const float*)d_in[19]; const float* mw_e = (const float*)d_in[20]; const float* mb_e = (const float*)d_in[21];
    const float* mw_gate = (const float*)d_in[22]; const float* mw_up = (const float*)d_in[23]; const float* mw_down = (const float*)d_in[24]; const float* ln2_g = (const float*)d_in[25]; const float* ln2_b = (const float*)d_in[26];
    unsigned char* ws = (unsigned char*)d_ws; float* out = (float*)d_out;
    bf16* WIN = (bf16*)(ws + WS_WIN); bf16* WB = (bf16*)(ws + WS_WB); bf16* WO = (bf16*)(ws + WS_WO); bf16* WGLU = (bf16*)(ws + WS_WGLU); bf16* WG = (bf16*)(ws + WS_WG); bf16* WU = (bf16*)(ws + WS_WU); bf16* WD = (bf16*)(ws + WS_WD);
    float* ROPE = (float*)(ws + WS_ROPE); bf16* XB = (bf16*)(ws + WS_XB); bf16* PROJ = (bf16*)(ws + WS_PROJ); bf16* GL = (bf16*)(ws + WS_GL); bf16* GY = (bf16*)(ws + WS_GY); bf16* BR = (bf16*)(ws + WS_BR);
    bf16* OD = (bf16*)(ws + WS_OD); float* CB = (float*)(ws + WS_CB); float* LOGF = (float*)(ws + WS_LOGF); float* GATE = (float*)(ws + WS_ROUTE);
    bf16* P = (bf16*)(ws + WS_P); bf16* MG = (bf16*)(ws + WS_MG); float* MIX = (float*)(ws + WS_MIX); bf16* HG = (bf16*)(ws + WS_HG); bf16* HU = (bf16*)(ws + WS_HU); float* FF = (float*)(ws + WS_FF);
    static int grid = 0;
    if (!grid) {
        int dev = 0, cus = 0; (void)hipGetDevice(&dev); (void)hipDeviceGetAttribute(&cus, hipDeviceAttributeMultiprocessorCount, dev);
        (void)hipFuncSetAttribute((const void*)mk_kernel, hipFuncAttributeMaxDynamicSharedMemorySize, LDS_BYTES);
        grid = cus > 0 ? cus : 256;
    }
    const int G = grid;
    (void)hipMemsetAsync(ws + WS_CTL, 0, CTL_ZERO_BYTES, stream);
    MkArgs a; memset(&a, 0, sizeof(a));
    for (int i = 0; i < 27; ++i) a.in[i] = (const float*)d_in[i];
    a.out = out; a.ws = ws;
    for (int l = 0; l < DEPTH; ++l) a.lam_init[l] = (float)(0.8 - 0.6 * exp(-0.3 * (double)l));
    {   ConvArgs& A = a.conv;
        add_job(A, w_in, (long)DM * D_IN, WIN, 1024, 512, D_IN, 0, 1, 0, 0, 1024, 0);
        add_job(A, w_in, (long)DM * D_IN, WIN + (size_t)512 * 1024, 1024, 1024, D_IN, 512, 1, 0, 0, 1024, 1);
        add_job(A, w_in, (long)DM * D_IN, WIN + (size_t)1536 * 1024, 1024, 2048, D_IN, 1536, 1, 0, 0, 1024, 0);
        add_job(A, w_in, (long)DM * D_IN, WIN + (size_t)3584 * 1024, 1024, 3072, D_IN, C_GL, 1, 0, 0, 1024, 0);
        add_job(A, w_branch, 3L * 512 * 1024, WB, 512, 1024, 1024, 0, 3, 512 * 1024, 1024 * 512, 512, 0);
        add_job(A, w_out, 1024L * 1024, WO, 1024, 1024, 1024, 0, 1, 0, 0, 1024, 0);
        add_job(A, w_glu, 512L * 1024, WGLU, 512, 1024, 1024, 0, 1, 0, 0, 512, 2);
        A.nitemsA = A.nitems;
        add_job(A, mw_gate, 16L * 1024 * 256, WG, 1024, 256, 256, 0, 16, 1024 * 256, 512 * 1024, 1024, 3);
        add_job(A, mw_up, 16L * 1024 * 256, WG, 1024, 256, 256, 0, 16, 1024 * 256, 512 * 1024, 1024, 4);
        add_job(A, mw_down, 16L * 256 * 1024, WD, 4096, 1024, 1024, 0, 1, 0, 0, 4096, 0); }
    for (int k = 0; k < 12; ++k) a.rep[k] = 1;
#ifdef PROBE_REP
    { const int pr[] = {PROBE_REP}; for (unsigned k = 0; k < sizeof(pr) / sizeof(int); ++k) a.rep[pr[k]] = 2; }
#endif
    a.layer_lo = 0; a.layer_hi = DEPTH; a.ph_lo = 0; a.ph_hi = NPH; a.bar_region = 0;
    hipLaunchKernelGGL(mk_kernel, dim3(G), dim3(NWAVES * 64), LDS_BYTES, stream, a);
}
```

```cpp
#include <hip/hip_runtime.h>
#include <cstdio>
#include <cstdint>
#include <cstring>
namespace pg8 {
#define PG8_LAS __attribute__((address_space(3)))
typedef unsigned short bf16_t;
typedef short bf16x8 __attribute__((ext_vector_type(8)));
typedef float f32x4 __attribute__((ext_vector_type(4)));
typedef unsigned u32x4 __attribute__((ext_vector_type(4)));
constexpr int BM = 256, BK = 64, HALF = 128, HTB = HALF * BK * 2  , STAGE_BYTES = 8 * HTB, NXCD = 8, WGM = 8;

__host__ __device__ __forceinline__ int lds_byte(int r, int c) { const int st = (r >> 4) * 2 + (c >> 5), rr = r & 15, cc = c & 31, ob = rr * 64 + cc * 2; return st * 1024 + (ob ^ (((ob >> 9) & 1) << 5)); }
__host__ __device__ __forceinline__ void stage_rc(int b, int& R, int& C) { const int st = b / 1024, sb = b % 1024, swz = sb ^ (((sb >> 9) & 1) << 5); R = (st >> 1) * 16 + swz / 64; C = (st & 1) * 32 + (swz % 64) / 2; }
__host__ __device__ __forceinline__ int perm32(int rho) { const int n = rho >> 4, i = rho & 15; return 8 * (i >> 2) + 4 * n + (i & 3); }

struct Unit { int pm, pn, z; };
struct Gemm { const bf16_t* A; const bf16_t* Bt; long zA, zB; int M, N, K, lda, ldb, pad; };

struct StaticOrder {
    int nM, nN, nwg, G, c;
    __host__ __device__ void init(int M, int N, int G_, int c_) { nM = M / BM; nN = N / BM; nwg = nM * nN; G = G_; c = c_; }
    __host__ __device__ bool next(int i, Unit& u) const {
        const long L = (long)i * G + c; if (L >= nwg) return false;
        int wgid = (int)L; { const int q = nwg / NXCD, r = nwg % NXCD, xcd = wgid % NXCD, off = wgid / NXCD; wgid = (xcd < r ? xcd * (q + 1) : r * (q + 1) + (xcd - r) * q) + off; }
        const int nig = WGM * nN, gid = wgid / nig, fm = gid * WGM, gsz = (nM - fm) < WGM ? (nM - fm) : WGM;
        u.pm = fm + ((wgid % nig) % gsz); u.pn = (wgid % nig) / gsz; u.z = 0; return true;
    }
    __device__ __forceinline__ void a_ready(const Unit&) const {}
    __device__ __forceinline__ void done(const Unit&) const {}
};

typedef float f32x2_cv __attribute__((ext_vector_type(2))); typedef __bf16 bf16x2_cv __attribute__((ext_vector_type(2)));
__device__ __forceinline__ unsigned cvt_pk_bf16(float lo, float hi) { f32x2_cv v = {lo, hi}; bf16x2_cv b = __builtin_convertvector(v, bf16x2_cv); return __builtin_bit_cast(unsigned, b); }
typedef float f32x2 __attribute__((ext_vector_type(2)));

struct BatchOrder {
    StaticOrder T; int nz;
    __host__ __device__ void init(int M, int N, int nz_, int G_, int c_) { T.init(M, N, G_, c_); nz = nz_; }
    __host__ __device__ bool next(int i, Unit& u) const { const int j = i / nz; if (!T.next(j, u)) return false; u.z = i - j * nz; return true; }
    __device__ __forceinline__ void a_ready(const Unit&) const {}
    __device__ __forceinline__ void done(const Unit&) const {}
};
struct EpiStoreBf16 {
    static constexpr bool PERM = true, AFTER_DRAIN = false, CHAIN = false;
    bf16_t* O; int ldc, pad; long zO;
    __device__ __forceinline__ void operator()(const f32x4 (&acc)[2][2][4][2], const Unit& u, int wr, int wc, int fr, int fq) const {
        const int row0 = u.pm * BM + wr * 64 + fr, col0 = u.pn * BM + wc * 32 + 8 * fq;
#pragma unroll
        for (int ai = 0; ai < 2; ++ai)
#pragma unroll
            for (int m = 0; m < 4; ++m) { bf16_t* rowp = O + (size_t)u.z * zO + (size_t)(row0 + ai * HALF + m * 16) * ldc + col0;
#pragma unroll
                for (int bj = 0; bj < 2; ++bj) { const f32x4 v0 = acc[ai][bj][m][0], v1 = acc[ai][bj][m][1];
                    u32x4 w; w.x = cvt_pk_bf16(v0[0], v0[1]); w.y = cvt_pk_bf16(v0[2], v0[3]); w.z = cvt_pk_bf16(v1[0], v1[1]); w.w = cvt_pk_bf16(v1[2], v1[3]);
                    *(u32x4*)(rowp + bj * HALF) = w; } }
    }
};
struct EpiStoreF32 {
    static constexpr bool PERM = false, AFTER_DRAIN = false, CHAIN = false;
    float* C; int ldc, pad;
    __device__ __forceinline__ void operator()(const f32x4 (&acc)[2][2][4][2], const Unit& u, int wr, int wc, int fr, int fq) const {
        const int row0 = u.pm * BM + wr * 64 + fr, col0 = u.pn * BM + wc * 32 + 4 * fq;
#pragma unroll
        for (int ai = 0; ai < 2; ++ai)
#pragma unroll
            for (int m = 0; m < 4; ++m) { float* rowp = C + (size_t)(row0 + ai * HALF + m * 16) * ldc + col0;
#pragma unroll
                for (int bj = 0; bj < 2; ++bj)
#pragma unroll
                    for (int n = 0; n < 2; ++n) *(f32x4*)(rowp + bj * HALF + n * 16) = acc[ai][bj][m][n]; }
    }
};
__device__ __forceinline__ float sigm(float z) { return __builtin_amdgcn_rcpf(1.f + __builtin_amdgcn_exp2f(-1.4426950408889634f * z)); }
typedef unsigned u32x2 __attribute__((ext_vector_type(2)));
struct EpiInProj {
    static constexpr bool PERM = true, AFTER_DRAIN = false, CHAIN = false;
    bf16_t* PROJ; bf16_t* GL; const float* rope; float c2; int pad;
    __device__ __forceinline__ void operator()(const f32x4 (&acc)[2][2][4][2], const Unit& u, int wr, int wc, int fr, int fq) const {
        const int row0 = u.pm * BM + wr * 64 + fr, pn = u.pn;
        if (pn >= 14) {
            const int col0 = (pn - 14) * BM + wc * 32 + 8 * fq;
#pragma unroll
            for (int ai = 0; ai < 2; ++ai)
#pragma unroll
                for (int m = 0; m < 4; ++m) { bf16_t* rowp = GL + (size_t)(row0 + ai * HALF + m * 16) * 3072 + col0;
#pragma unroll
                    for (int bj = 0; bj < 2; ++bj) { const f32x4 v0 = acc[ai][bj][m][0], v1 = acc[ai][bj][m][1];
                        u32x4 w; w.x = cvt_pk_bf16(sigm(v0[0]), sigm(v0[1])); w.y = cvt_pk_bf16(sigm(v0[2]), sigm(v0[3])); w.z = cvt_pk_bf16(sigm(v1[0]), sigm(v1[1])); w.w = cvt_pk_bf16(sigm(v1[2]), sigm(v1[3]));
                        *(u32x4*)(rowp + bj * HALF) = w; } }
        } else if (pn >= 2 && pn < 6) {
            const float sc = pn < 4 ? c2 : 1.f; const int q4 = 4 * (4 * (wc & 1) + fq);
#pragma unroll
            for (int ai = 0; ai < 2; ++ai)
#pragma unroll
                for (int m = 0; m < 4; ++m) { const int row = row0 + ai * HALF + m * 16, s = row & 2047;
                    const f32x4 cs = *(const f32x4*)(rope + s * 32 + q4) * sc, sn = *(const f32x4*)(rope + 65536 + s * 32 + q4) * sc;
                    bf16_t* rowp = PROJ + (size_t)row * 3584 + pn * BM + 64 * (wc >> 1) + q4;
#pragma unroll
                    for (int bj = 0; bj < 2; ++bj) { const f32x4 t1 = acc[ai][bj][m][0], t2 = acc[ai][bj][m][1]; const f32x4 o1 = t1 * cs - t2 * sn, o2 = t2 * cs + t1 * sn;
                        u32x2 w1, w2; w1.x = cvt_pk_bf16(o1[0], o1[1]); w1.y = cvt_pk_bf16(o1[2], o1[3]); w2.x = cvt_pk_bf16(o2[0], o2[1]); w2.y = cvt_pk_bf16(o2[2], o2[3]);
                        *(u32x2*)(rowp + bj * HALF) = w1; *(u32x2*)(rowp + bj * HALF + 32) = w2; } }
        } else {
            const float sc = (pn == 8 || pn == 9) ? c2 : 1.f; const int col0 = pn * BM + wc * 32 + 8 * fq;
#pragma unroll
            for (int ai = 0; ai < 2; ++ai)
#pragma unroll
                for (int m = 0; m < 4; ++m) { bf16_t* rowp = PROJ + (size_t)(row0 + ai * HALF + m * 16) * 3584 + col0;
#pragma unroll
                    for (int bj = 0; bj < 2; ++bj) { const f32x4 v0 = acc[ai][bj][m][0] * sc, v1 = acc[ai][bj][m][1] * sc;
                        u32x4 w; w.x = cvt_pk_bf16(v0[0], v0[1]); w.y = cvt_pk_bf16(v0[2], v0[3]); w.z = cvt_pk_bf16(v1[0], v1[1]); w.w = cvt_pk_bf16(v1[2], v1[3]);
                        *(u32x4*)(rowp + bj * HALF) = w; } }
        }
    }
};
struct EpiGlu {
    static constexpr bool PERM = true, AFTER_DRAIN = false, CHAIN = false;
    bf16_t* YS; int ldc, pad;
    __device__ __forceinline__ void operator()(const f32x4 (&acc)[2][2][4][2], const Unit& u, int wr, int wc, int fr, int fq) const {
        const int row0 = u.pm * BM + wr * 64 + fr, col0 = u.pn * 128 + 16 * wc + 4 * fq;
#pragma unroll
        for (int ai = 0; ai < 2; ++ai)
#pragma unroll
            for (int m = 0; m < 4; ++m) { bf16_t* rowp = YS + (size_t)(row0 + ai * HALF + m * 16) * ldc + col0;
#pragma unroll
                for (int bj = 0; bj < 2; ++bj) { const f32x4 v = acc[ai][bj][m][0], g = acc[ai][bj][m][1];
                    u32x2 w; w.x = cvt_pk_bf16(v[0] * sigm(g[0]), v[1] * sigm(g[1])); w.y = cvt_pk_bf16(v[2] * sigm(g[2]), v[3] * sigm(g[3]));
                    *(u32x2*)(rowp + bj * 64) = w; } }
    }
};

struct MoeTables { const PG8_LAS int* tb; const PG8_LAS int* cnt; };
template <int NCT> struct MoeOrder {
    MoeTables T; const int* tokl; int G, c, lda2;
    __device__ __forceinline__ bool next(int i, Unit& u) const {
        const int L = i * G + c, rt = L / NCT; if (rt >= __builtin_amdgcn_readfirstlane(T.tb[16])) return false;
        const int e = __builtin_amdgcn_readfirstlane(T.tb[64 + rt]);
        u.pm = rt; u.pn = L - rt * NCT; u.z = e; return true;
    }
    __device__ __forceinline__ unsigned a_off(const Unit& u, int row) const {
        const int pos = (u.pm - __builtin_amdgcn_readfirstlane(T.tb[u.z])) * 256 + row; const int tok = tokl[u.z * 16384 + (pos < __builtin_amdgcn_readfirstlane(T.cnt[u.z]) ? pos : 0)];
        return (unsigned)tok * (unsigned)lda2;
    }
    __device__ __forceinline__ void a_ready(const Unit&) const {}
    __device__ __forceinline__ void done(const Unit&) const {}
};
template <int NCT> struct MoeTileOrder {
    MoeTables T; const int* tokl; int rt0, step, lda2;
    __device__ __forceinline__ bool next(int i, Unit& u) const {
        const int rt = rt0 + (i / NCT) * step; if (rt >= __builtin_amdgcn_readfirstlane(T.tb[16])) return false;
        u.pm = rt; u.pn = i % NCT; u.z = __builtin_amdgcn_readfirstlane(T.tb[64 + rt]); return true;
    }
    __device__ __forceinline__ unsigned a_off(const Unit& u, int row) const {
        const int pos = (u.pm - __builtin_amdgcn_readfirstlane(T.tb[u.z])) * 256 + row; const int tok = tokl[u.z * 16384 + (pos < __builtin_amdgcn_readfirstlane(T.cnt[u.z]) ? pos : 0)];
        return (unsigned)tok * (unsigned)lda2;
    }
    __device__ __forceinline__ void a_ready(const Unit&) const {}
    __device__ __forceinline__ void done(const Unit&) const {}
};
struct EpiMoeUp {
    static constexpr bool PERM = true, AFTER_DRAIN = false, CHAIN = false;
    bf16_t* H; const float* wl; MoeTables T;
    __device__ __forceinline__ void operator()(const f32x4 (&acc)[2][2][4][2], const Unit& u, int wr, int wc, int fr, int fq) const {
        const int r0 = wr * 64 + fr, col0 = u.pn * 128 + 16 * wc + 4 * fq, e = u.z, pos0 = (u.pm - __builtin_amdgcn_readfirstlane(T.tb[e])) * 256, n = __builtin_amdgcn_readfirstlane(T.cnt[e]);
#pragma unroll
        for (int ai = 0; ai < 2; ++ai)
#pragma unroll
            for (int m = 0; m < 4; ++m) { const int r = r0 + ai * HALF + m * 16, pos = pos0 + r; const float w = pos < n ? wl[e * 16384 + pos] : 0.f;
                bf16_t* rowp = H + (size_t)(u.pm * 256 + r) * 256 + col0;
#pragma unroll
                for (int bj = 0; bj < 2; ++bj) { const f32x4 gt = acc[ai][bj][m][0], up = acc[ai][bj][m][1];
                    u32x2 o; o.x = cvt_pk_bf16(gt[0] * sigm(gt[0]) * up[0] * w, gt[1] * sigm(gt[1]) * up[1] * w); o.y = cvt_pk_bf16(gt[2] * sigm(gt[2]) * up[2] * w, gt[3] * sigm(gt[3]) * up[3] * w);
                    *(u32x2*)(rowp + bj * 64) = o; } }
    }
};

struct EpiGatedChain {
    static constexpr bool PERM = true, AFTER_DRAIN = false, CHAIN = true;
    bf16_t* MG; const bf16_t* GL;
    __device__ __forceinline__ bool keep(const Unit& u) const { return u.z < 2; }
    __device__ __forceinline__ void chain(f32x4 (&acc)[2][2][4][2], const Unit& u, int wr, int wc, int fr, int fq) const {
        const int row0 = u.pm * BM + wr * 64 + fr, col0 = u.pn * BM + wc * 32 + 8 * fq, z = u.z; const float eps = 5.9604645e-08f;
#pragma unroll
        for (int ai = 0; ai < 2; ++ai)
#pragma unroll
            for (int m = 0; m < 4; ++m) { const size_t row = (size_t)(row0 + ai * HALF + m * 16); const bf16_t* gp = GL + row * 3072 + z * 1024 + col0;
#pragma unroll
                for (int bj = 0; bj < 2; ++bj) { const u32x4 ga = *(const u32x4*)(gp + bj * HALF); float f[8];
                    f[0] = __builtin_bit_cast(float, ga.x << 16); f[1] = __builtin_bit_cast(float, ga.x & 0xffff0000u); f[2] = __builtin_bit_cast(float, ga.y << 16); f[3] = __builtin_bit_cast(float, ga.y & 0xffff0000u);
                    f[4] = __builtin_bit_cast(float, ga.z << 16); f[5] = __builtin_bit_cast(float, ga.z & 0xffff0000u); f[6] = __builtin_bit_cast(float, ga.w << 16); f[7] = __builtin_bit_cast(float, ga.w & 0xffff0000u);
#pragma unroll
                    for (int e = 0; e < 8; ++e) f[e] = fmaxf(f[e], eps);
                    if (z < 2) { const u32x4 gb = *(const u32x4*)(gp + 1024 + bj * HALF); float d[8];
                        d[0] = __builtin_bit_cast(float, gb.x << 16); d[1] = __builtin_bit_cast(float, gb.x & 0xffff0000u); d[2] = __builtin_bit_cast(float, gb.y << 16); d[3] = __builtin_bit_cast(float, gb.y & 0xffff0000u);
                        d[4] = __builtin_bit_cast(float, gb.z << 16); d[5] = __builtin_bit_cast(float, gb.z & 0xffff0000u); d[6] = __builtin_bit_cast(float, gb.w << 16); d[7] = __builtin_bit_cast(float, gb.w & 0xffff0000u);
#pragma unroll
                        for (int e = 0; e < 8; ++e) f[e] = f[e] * __builtin_amdgcn_rcpf(fmaxf(d[e], eps)); }
                    f32x4& v0 = acc[ai][bj][m][0]; f32x4& v1 = acc[ai][bj][m][1];
                    v0[0] *= f[0]; v0[1] *= f[1]; v0[2] *= f[2]; v0[3] *= f[3]; v1[0] *= f[4]; v1[1] *= f[5]; v1[2] *= f[6]; v1[3] *= f[7];
                    if (z == 2) { u32x4 w; w.x = cvt_pk_bf16(v0[0], v0[1]); w.y = cvt_pk_bf16(v0[2], v0[3]); w.z = cvt_pk_bf16(v1[0], v1[1]); w.w = cvt_pk_bf16(v1[2], v1[3]);
                        *(u32x4*)(MG + row * 1024 + col0 + bj * HALF) = w; } }
                if (m & 1) asm volatile("" ::: "memory"); }
    }
};
template <class Epi, class Sched, bool ALIGN_EPI = false, bool SP2 = false, bool GATHER = false>
__device__ __forceinline__ void gemm_phase(PG8_LAS unsigned char* lds, const Gemm g, const Sched& S, const Epi& E) {
    int tid_ = threadIdx.x; asm volatile("" : "+v"(tid_));
    const int tid = tid_, wid = __builtin_amdgcn_readfirstlane(tid >> 6), lane = tid & 63, wr = wid >> 2, wc = wid & 3, fr = lane & 15, fq = lane >> 4;
    const int K = g.K, nt = K / BK;
    unsigned voffA[2], voffB[2]; int rowA[2], colA2[2];
#pragma unroll
    for (int i = 0; i < 2; ++i) { int R, C; stage_rc(tid * 16 + i * 8192, R, C); const int Rb = Epi::PERM ? ((R & ~31) + perm32(R & 31)) : R;
        voffA[i] = (unsigned)(R * g.lda + C) * 2u; voffB[i] = (unsigned)(Rb * g.ldb + C) * 2u; rowA[i] = R; colA2[i] = C * 2; }
    unsigned gC[2][2], gN[2][2], g2[2][2];
#define PG8_VAC(h) (GATHER ? gC[h] : voffA)
#define PG8_VA2(h) (GATHER ? g2[h] : voffA)
#define PG8_GOFF(dst, u) do { if constexpr (GATHER) { _Pragma("unroll") for (int h_ = 0; h_ < 2; ++h_) _Pragma("unroll") for (int i_ = 0; i_ < 2; ++i_) dst[h_][i_] = S.a_off(u, 128 * h_ + rowA[i_]) + (unsigned)colA2[i_]; } } while (0)
    const size_t kstep = (size_t)(BK * 2);
    const size_t hstepA = GATHER ? (size_t)0 : (size_t)HALF * g.lda * 2, hstepB = (size_t)HALF * g.ldb * 2;
    const size_t tstepA = 2 * hstepA, tstepB = 2 * hstepB;
    const unsigned ldsw = (unsigned)wid * 1024u;
    const int aoff = lds_byte(wr * 64 + fr, fq * 8), boff = lds_byte(wc * 32 + fr, fq * 8);
#define PG8_SA(b, h) (((b) * 2 + (h)) * HTB)
#define PG8_SB(b, h) ((4 + (b) * 2 + (h)) * HTB)
#define PG8_STAGE(bufoff, gbase, voff) do { _Pragma("unroll") for (int _i = 0; _i < 2; ++_i) \
        __builtin_amdgcn_global_load_lds((const unsigned*)((const char*)(gbase) + (voff)[_i]), (PG8_LAS unsigned*)(lds + (bufoff) + ldsw + _i * 8192), 16, 0, 0); } while (0)
#define PG8_LDA(dst, b, h) do { _Pragma("unroll") for (int m = 0; m < 4; ++m) _Pragma("unroll") for (int k = 0; k < 2; ++k) dst[m][k] = *(const PG8_LAS bf16x8*)(lds + PG8_SA(b, h) + aoff + m * 2048 + k * 1024); } while (0)
#define PG8_LDB(dst, b, h) do { _Pragma("unroll") for (int n = 0; n < 2; ++n) _Pragma("unroll") for (int k = 0; k < 2; ++k) dst[n][k] = *(const PG8_LAS bf16x8*)(lds + PG8_SB(b, h) + boff + n * 2048 + k * 1024); } while (0)
#define PG8_MMA(ai, bj, At, Bt) do { __builtin_amdgcn_s_setprio(1); _Pragma("unroll") for (int m = 0; m < 4; ++m) _Pragma("unroll") for (int n = 0; n < 2; ++n) _Pragma("unroll") for (int k = 0; k < 2; ++k) \
        acc[ai][bj][m][n] = __builtin_amdgcn_mfma_f32_16x16x32_bf16(Bt[n][k], At[m][k], acc[ai][bj][m][n], 0, 0, 0); __builtin_amdgcn_s_setprio(0); } while (0)
#define PG8_WAIT_V(n) asm volatile("s_waitcnt vmcnt(" #n ")" ::: "memory")
#define PG8_WAIT_L(n) asm volatile("s_waitcnt lgkmcnt(" #n ")" ::: "memory")
#define PG8_BAR __builtin_amdgcn_s_barrier()
#define PG8_SCHED __builtin_amdgcn_sched_barrier(0)
    Unit cur, nxt; int ui = 0;
    if (!S.next(0, cur)) return;
    f32x4 acc[2][2][4][2];
    { float z_ = 0.f; asm volatile("" : "+v"(z_));
#pragma unroll
    for (int a = 0; a < 2; ++a)
#pragma unroll
        for (int b = 0; b < 2; ++b)
#pragma unroll
            for (int m = 0; m < 4; ++m)
#pragma unroll
                for (int n = 0; n < 2; ++n) acc[a][b][m][n] = (f32x4){z_, z_, z_, z_}; }
    bf16x8 At[4][2], B0[2][2], B1[2][2];
    const char* cA = (const char*)g.A + (GATHER ? (size_t)0 : (size_t)cur.pm * tstepA) + (size_t)cur.z * g.zA; const char* cB = (const char*)g.Bt + (size_t)cur.pn * tstepB + (size_t)cur.z * g.zB;
    S.a_ready(cur);
    PG8_GOFF(gC, cur);
    if constexpr (SP2) {
        PG8_STAGE(PG8_SB(0, 0), cB, voffB); PG8_STAGE(PG8_SB(0, 1), cB + hstepB, voffB); PG8_STAGE(PG8_SA(0, 0), cA, PG8_VAC(0)); PG8_STAGE(PG8_SA(0, 1), cA + hstepA, PG8_VAC(1));
        if (wr == 1) PG8_BAR;
        PG8_WAIT_V(2); PG8_BAR;
        PG8_STAGE(PG8_SB(1, 0), cB + kstep, voffB); PG8_STAGE(PG8_SA(1, 0), cA + kstep, PG8_VAC(0)); PG8_STAGE(PG8_SB(1, 1), cB + hstepB + kstep, voffB);
        PG8_WAIT_V(6); PG8_BAR;
    } else {
        PG8_STAGE(PG8_SB(0, 0), cB, voffB); PG8_STAGE(PG8_SA(0, 0), cA, PG8_VAC(0)); PG8_STAGE(PG8_SB(0, 1), cB + hstepB, voffB); PG8_STAGE(PG8_SA(0, 1), cA + hstepA, PG8_VAC(1));
        if (wr == 1) PG8_BAR;
        PG8_WAIT_V(4); PG8_BAR;
        PG8_STAGE(PG8_SB(1, 0), cB + kstep, voffB); PG8_STAGE(PG8_SA(1, 0), cA + kstep, PG8_VAC(0)); PG8_STAGE(PG8_SB(1, 1), cB + hstepB + kstep, voffB);
        PG8_WAIT_V(6); PG8_BAR;
    }
    for (;;) {
        const bool has_next = S.next(ui + 1, nxt);
        if constexpr (GATHER) { if (has_next) PG8_GOFF(gN, nxt); else { _Pragma("unroll") for (int h_ = 0; h_ < 2; ++h_) _Pragma("unroll") for (int i_ = 0; i_ < 2; ++i_) gN[h_][i_] = gC[h_][i_]; } }
        const char* nA = has_next ? (const char*)g.A + (GATHER ? (size_t)0 : (size_t)nxt.pm * tstepA) + (size_t)nxt.z * g.zA : cA; const char* nB = has_next ? (const char*)g.Bt + (size_t)nxt.pn * tstepB + (size_t)nxt.z * g.zB : cB;
#pragma unroll 1
        for (int t = 0; t < nt; t += 2) {
            const bool last = (t == nt - 2);
            if constexpr (GATHER) { _Pragma("unroll") for (int h_ = 0; h_ < 2; ++h_) _Pragma("unroll") for (int i_ = 0; i_ < 2; ++i_) g2[h_][i_] = last ? gN[h_][i_] : gC[h_][i_]; }
            const char* a1 = cA + (size_t)(t + 1) * kstep;
            const char* a2 = last ? nA : cA + (size_t)(t + 2) * kstep; const char* b2 = last ? nB : cB + (size_t)(t + 2) * kstep;
            const char* a3 = a2 + kstep; const char* b3 = b2 + kstep;
            if (last && has_next) S.a_ready(nxt);
            if constexpr (SP2) {
            PG8_LDB(B0, 0, 0); PG8_LDB(B1, 0, 1); PG8_SCHED; PG8_LDA(At, 0, 0); PG8_STAGE(PG8_SA(1, 1), a1 + hstepA, PG8_VAC(1));
            PG8_WAIT_V(8); PG8_WAIT_L(0); PG8_BAR; PG8_MMA(0, 0, At, B0); PG8_MMA(0, 1, At, B1); PG8_BAR; PG8_SCHED;
            PG8_LDA(At, 0, 1); PG8_STAGE(PG8_SB(0, 0), b2, voffB); PG8_STAGE(PG8_SB(0, 1), b2 + hstepB, voffB); PG8_STAGE(PG8_SA(0, 0), a2, PG8_VA2(0));
            PG8_WAIT_V(8); PG8_WAIT_L(0); PG8_BAR; PG8_MMA(1, 0, At, B0); PG8_MMA(1, 1, At, B1); PG8_BAR; PG8_SCHED;
            PG8_LDB(B0, 1, 0); PG8_LDB(B1, 1, 1); PG8_SCHED; PG8_LDA(At, 1, 0); PG8_STAGE(PG8_SA(0, 1), a2 + hstepA, PG8_VA2(1));
            PG8_WAIT_V(8); PG8_WAIT_L(0); PG8_BAR; PG8_MMA(0, 0, At, B0); PG8_MMA(0, 1, At, B1); PG8_BAR; PG8_SCHED;
            PG8_LDA(At, 1, 1); PG8_STAGE(PG8_SB(1, 0), b3, voffB); PG8_STAGE(PG8_SB(1, 1), b3 + hstepB, voffB); PG8_STAGE(PG8_SA(1, 0), a3, PG8_VA2(0));
            PG8_WAIT_V(8); PG8_WAIT_L(0); PG8_BAR; PG8_MMA(1, 0, At, B0); PG8_MMA(1, 1, At, B1); PG8_BAR; PG8_SCHED;
            } else {
            PG8_LDB(B0, 0, 0); PG8_SCHED; PG8_LDA(At, 0, 0); PG8_STAGE(PG8_SA(1, 1), a1 + hstepA, PG8_VAC(1));
            PG8_WAIT_L(8); PG8_BAR; PG8_WAIT_L(0); PG8_MMA(0, 0, At, B0); PG8_BAR; PG8_SCHED;
            PG8_LDB(B1, 0, 1); PG8_STAGE(PG8_SB(0, 0), b2, voffB);
            PG8_BAR; PG8_WAIT_L(0); PG8_MMA(0, 1, At, B1); PG8_BAR;
            PG8_LDA(At, 0, 1); PG8_STAGE(PG8_SA(0, 0), a2, PG8_VA2(0));
            PG8_BAR; PG8_WAIT_L(0); PG8_MMA(1, 0, At, B0); PG8_BAR; PG8_SCHED;
            PG8_STAGE(PG8_SB(0, 1), b2 + hstepB, voffB);
            PG8_WAIT_V(6); PG8_BAR; PG8_MMA(1, 1, At, B1); PG8_BAR;
            PG8_LDB(B0, 1, 0); PG8_SCHED; PG8_LDA(At, 1, 0); PG8_STAGE(PG8_SA(0, 1), a2 + hstepA, PG8_VA2(1));
            PG8_WAIT_L(8); PG8_BAR; PG8_WAIT_L(0); PG8_MMA(0, 0, At, B0); PG8_BAR; PG8_SCHED;
            PG8_LDB(B1, 1, 1); PG8_STAGE(PG8_SB(1, 0), b3, voffB);
            PG8_BAR; PG8_WAIT_L(0); PG8_MMA(0, 1, At, B1); PG8_BAR;
            PG8_LDA(At, 1, 1); PG8_STAGE(PG8_SA(1, 0), a3, PG8_VA2(0));
            PG8_BAR; PG8_WAIT_L(0); PG8_MMA(1, 0, At, B0); PG8_BAR; PG8_SCHED;
            PG8_STAGE(PG8_SB(1, 1), b3 + hstepB, voffB);
            PG8_WAIT_V(6); PG8_BAR; PG8_MMA(1, 1, At, B1); PG8_BAR;
            }
        }
        if constexpr (ALIGN_EPI) { if (wr == 0) PG8_BAR; }
        if constexpr (Epi::CHAIN) { E.chain(acc, cur, wr, wc, fr, fq); S.done(cur); }
        else if constexpr (!Epi::AFTER_DRAIN) { E(acc, cur, wr, wc, fr, fq); S.done(cur); }
        if (!has_next) break;
        bool keep_ = false; if constexpr (Epi::CHAIN) keep_ = E.keep(cur);
        if (!keep_) { float z_ = 0.f; asm volatile("" : "+v"(z_));
#pragma unroll
        for (int a = 0; a < 2; ++a)
#pragma unroll
            for (int b = 0; b < 2; ++b)
#pragma unroll
                for (int m = 0; m < 4; ++m)
#pragma unroll
                    for (int n = 0; n < 2; ++n) acc[a][b][m][n] = (f32x4){z_, z_, z_, z_}; }
        cur = nxt; cA = nA; cB = nB; ++ui;
        if constexpr (GATHER) { _Pragma("unroll") for (int h_ = 0; h_ < 2; ++h_) _Pragma("unroll") for (int i_ = 0; i_ < 2; ++i_) gC[h_][i_] = gN[h_][i_]; }
        if constexpr (ALIGN_EPI) { if (wr == 1) PG8_BAR; }
    }
    PG8_WAIT_V(0);
    if constexpr (!ALIGN_EPI) { if (wr == 0) PG8_BAR; }
    PG8_BAR;
    if constexpr (Epi::AFTER_DRAIN) { E.fused(acc, cur, wr, wc, fr, fq, lds, wid, lane); S.done(cur); }
#undef PG8_SA
#undef PG8_VAC
#undef PG8_VA2
#undef PG8_GOFF
#undef PG8_SB
#undef PG8_STAGE
#undef PG8_LDA
#undef PG8_LDB
#undef PG8_MMA
#undef PG8_WAIT_V
#undef PG8_WAIT_L
#undef PG8_BAR
#undef PG8_SCHED
}
}
#include <hip/hip_bf16.h>
#include <cmath>
namespace attn_body {
using bf16=__hip_bfloat16;
using bf16x8=__attribute__((ext_vector_type(8)))short;
using s16x4=__attribute__((ext_vector_type(4)))short;
using f32x16=__attribute__((ext_vector_type(16)))float;
using u32x4=__attribute__((ext_vector_type(4)))unsigned;
constexpr int BATCH=8,SEQ=2048,D=64,DM=3584;
constexpr int NW=8,QBLK=32,QB=QBLK*NW,KVBLK=64,NQB=SEQ/QB;
constexpr int ATTN_PITCH=DM, ATTN_UNIT_ROWS=QB;
__device__ __forceinline__ int crow(int r,int hi){return (r&3)+8*(r>>2)+4*hi;}
#define SBAR() __builtin_amdgcn_sched_barrier(0)
__device__ __forceinline__ void cmask(f32x16&p0,f32x16&p1,int jb,int qrel,int hi){
  const float NEG=-INFINITY; int kb=64*jb+4*hi;
  #pragma unroll
  for(int r=0;r<16;++r){int kv=kb+(r&3)+8*(r>>2); if(kv>qrel)p0[r]=NEG; if(kv+32>qrel)p1[r]=NEG;}
}

constexpr int NSLOT=3, SLOTB=8192;
constexpr int LDS_K=0, LDS_V=NSLOT*SLOTB, LDS_WS=2*NSLOT*SLOTB, LDS_OST=LDS_WS+NW*64*4, LDS_BIAS=LDS_OST+NW*4096, LDS_BYTES=LDS_BIAS+SEQ*4;
constexpr float C2=0.125f*1.4426950408889634f;
__device__ __forceinline__ void glds16(const void*gsrc,unsigned lds_dst){unsigned keep;
  asm volatile("s_mov_b32 %0, m0\n\ts_mov_b32 m0, %2\n\ts_nop 0\n\tglobal_load_lds_dwordx4 %1, off\n\ts_mov_b32 m0, %0":"=&s"(keep):"v"(gsrc),"s"(lds_dst):"memory");}
__device__ __forceinline__ float max3f(float a,float b,float c){float r;asm("v_max3_f32 %0, %1, %2, %3":"=v"(r):"v"(a),"v"(b),"v"(c));return r;}
__device__ __forceinline__ float max2f(float a,float b){float r;asm("v_max_f32_e32 %0, %1, %2":"=v"(r):"v"(a),"v"(b));return r;}
__device__ __forceinline__ float fadd_s(float a,float b){float r;asm("v_add_f32_e32 %0, %1, %2":"=v"(r):"v"(a),"v"(b));return r;}
__device__ __forceinline__ float fsub_s(float a,float b){float r;asm("v_sub_f32_e32 %0, %1, %2":"=v"(r):"v"(a),"v"(b));return r;}
typedef float f32x2_t __attribute__((ext_vector_type(2))); typedef __bf16 bf16x2_t __attribute__((ext_vector_type(2)));
__device__ __forceinline__ unsigned cvtpk_s(float lo,float hi){f32x2_t v={lo,hi};bf16x2_t b=__builtin_convertvector(v,bf16x2_t);return __builtin_bit_cast(unsigned,b);}
#define WAIT_BAR(N) asm volatile("s_waitcnt vmcnt(" #N ") lgkmcnt(0)\n\ts_barrier":::"memory")

__device__ __forceinline__ void qkt(f32x16&p0,f32x16&p1,const char*Kslot,const bf16x8*qr,const f32x16&cin0,const f32x16&cin1,int r32,int hi){
  const char*kb=Kslot+hi*1024+r32*16;
  #pragma unroll
  for(int d0=0;d0<4;++d0){
    const bf16x8 b0=*reinterpret_cast<const bf16x8*>(kb+d0*2048);
    const bf16x8 b1=*reinterpret_cast<const bf16x8*>(kb+d0*2048+512);
    if(d0==0){p0=__builtin_amdgcn_mfma_f32_32x32x16_bf16(b0,qr[0],cin0,0,0,0);p1=__builtin_amdgcn_mfma_f32_32x32x16_bf16(b1,qr[0],cin1,0,0,0);}
    else{p0=__builtin_amdgcn_mfma_f32_32x32x16_bf16(b0,qr[d0],p0,0,0,0);p1=__builtin_amdgcn_mfma_f32_32x32x16_bf16(b1,qr[d0],p1,0,0,0);}}
}
typedef __attribute__((address_space(3))) const char* lds_cptr;
typedef short v4i16_t __attribute__((ext_vector_type(4)));
__device__ __forceinline__ void kload8(bf16x8*kf,lds_cptr kp){
  kf[0]=*(const __attribute__((address_space(3))) bf16x8*)(kp);      kf[1]=*(const __attribute__((address_space(3))) bf16x8*)(kp+512);
  kf[2]=*(const __attribute__((address_space(3))) bf16x8*)(kp+2048); kf[3]=*(const __attribute__((address_space(3))) bf16x8*)(kp+2560);
  kf[4]=*(const __attribute__((address_space(3))) bf16x8*)(kp+4096); kf[5]=*(const __attribute__((address_space(3))) bf16x8*)(kp+4608);
  kf[6]=*(const __attribute__((address_space(3))) bf16x8*)(kp+6144); kf[7]=*(const __attribute__((address_space(3))) bf16x8*)(kp+6656);
}
__device__ __forceinline__ void kload2(bf16x8*kf,lds_cptr kp,int j){ kf[2*j]=*(const __attribute__((address_space(3))) bf16x8*)(kp+j*2048); kf[2*j+1]=*(const __attribute__((address_space(3))) bf16x8*)(kp+j*2048+512); }
__device__ __forceinline__ s16x4 vtr(lds_cptr p){ return __builtin_bit_cast(s16x4,__builtin_amdgcn_ds_read_tr16_b64_v4i16((__attribute__((address_space(3))) v4i16_t*)p)); }
__device__ __forceinline__ float rowmax(const f32x16&p0,const f32x16&p1){
  float a=max3f(p0[0],p0[1],p1[0]),b=max3f(p0[2],p0[3],p1[1]);a=max3f(a,p1[2],p1[3]);
  #pragma unroll
  for(int r=4;r<16;r+=4){a=max3f(a,p0[r],p0[r+1]);b=max3f(b,p0[r+2],p0[r+3]);a=max3f(a,p1[r],p1[r+1]);b=max3f(b,p1[r+2],p1[r+3]);}
  const float m=max2f(a,b);
  auto rr=__builtin_amdgcn_permlane32_swap(__float_as_uint(m),__float_as_uint(m),false,false);
  return max2f(__uint_as_float(rr[0]),__uint_as_float(rr[1]));
}
__device__ __forceinline__ void pv(f32x16*o,int vb,bf16x8 pa0,bf16x8 pa1,bf16x8 pa2,bf16x8 pa3){
  #pragma unroll
  for(int d0=0;d0<2;++d0){s16x4 lo[4],hi[4];
    #pragma unroll
    for(int ks=0;ks<4;++ks){
      asm volatile("ds_read_b64_tr_b16 %0,%1 offset:%c2":"=&v"(lo[ks]):"v"(vb),"i"(d0*4096+ks*1024):"memory");
      asm volatile("ds_read_b64_tr_b16 %0,%1 offset:%c2":"=&v"(hi[ks]):"v"(vb),"i"(d0*4096+ks*1024+512):"memory");}
    asm volatile("s_waitcnt lgkmcnt(0)":::"memory");SBAR();
    #define PK(k) (bf16x8){lo[k][0],lo[k][1],lo[k][2],lo[k][3],hi[k][0],hi[k][1],hi[k][2],hi[k][3]}
    o[d0]=__builtin_amdgcn_mfma_f32_32x32x16_bf16(pa0,PK(0),o[d0],0,0,0);
    o[d0]=__builtin_amdgcn_mfma_f32_32x32x16_bf16(pa1,PK(1),o[d0],0,0,0);
    o[d0]=__builtin_amdgcn_mfma_f32_32x32x16_bf16(pa2,PK(2),o[d0],0,0,0);
    o[d0]=__builtin_amdgcn_mfma_f32_32x32x16_bf16(pa3,PK(3),o[d0],0,0,0);
    #undef PK
  }
}

#ifndef ATTN_STORE16
#define ATTN_STORE16(p,v) (*(u32x4*)(p)=(v))
#endif
template<int THRL,bool BIAS,int op> __device__ __forceinline__ void attn_unit(int b,int qb,const bf16*Qh,const bf16*__restrict__ Kh_,const bf16*__restrict__ Vh_,bf16*Oh,char*shm){
  int tid_=threadIdx.x; asm volatile("":"+v"(tid_));
  const int tid=tid_,lane=tid&63,r32=lane&31,hi=lane>>5; const int wid=__builtin_amdgcn_readfirstlane(tid>>6);
  const long rowbase=(long)b*SEQ; const int q0=qb*QB;
  const bf16*Qw=Qh+(rowbase+q0+wid*QBLK)*DM;
  const bf16*Kh=Kh_+rowbase*DM,*Vh=Vh_+rowbase*DM;
  typedef float f32x4_t __attribute__((ext_vector_type(4)));
  const __attribute__((address_space(3))) float* cb3=(const __attribute__((address_space(3))) float*)((__attribute__((address_space(3))) const char*)shm+LDS_BIAS)+4*hi;
  const unsigned lds0=(unsigned)(uintptr_t)shm;
  float*wsf=(float*)(shm+LDS_WS)+wid*64;
  const bf16*ksrc=Kh+(long)lane*DM+wid*8;
  const bf16*vsrc=Vh+(long)(16*(wid&3)+(lane>>2))*DM+(wid>>2)*32+(lane&3)*8;
  const unsigned kdst=lds0+LDS_K+wid*1024, vdst=lds0+LDS_V+wid*1024;
  #define DMA_K(t,slot) glds16(ksrc+(long)(t)*KVBLK*DM,(unsigned)__builtin_amdgcn_readfirstlane(kdst+(slot)))
  #define DMA_V(t,slot) glds16(vsrc+(long)(t)*KVBLK*DM,(unsigned)__builtin_amdgcn_readfirstlane(vdst+(slot)))
  const int vb0=(int)(lds0+LDS_V)+((lane>>4)&1)*32+(lane&3)*8+(4*hi+((lane&15)>>2))*64;
  const char*Kbase=shm+LDS_K; bf16x8 kf[8];
  const lds_cptr shm3=(lds_cptr)shm; const lds_cptr kp0=shm3+LDS_K+hi*1024+r32*16; const lds_cptr vp0=shm3+LDS_V+((lane>>4)&1)*32+(lane&3)*8+(4*hi+((lane&15)>>2))*64;
  const int NT=(q0+QB)/KVBLK;
  DMA_K(0,0);DMA_V(0,0);DMA_K(1,SLOTB);
  bf16x8 qr[4];
  #pragma unroll
  for(int d0=0;d0<4;++d0)qr[d0]=*reinterpret_cast<const bf16x8*>(&Qw[(long)r32*DM+d0*16+hi*8]);
  float mhat=0.f,l_reg=0.f;f32x16 o[2];float z_=0.f;asm volatile("":"+v"(z_));
  _Pragma("unroll") for(int r=0;r<16;++r){o[0][r]=z_;o[1][r]=z_;} f32x16 negm; _Pragma("unroll") for(int r=0;r<16;++r)negm[r]=z_; asm volatile("":"+v"(negm));
  const int qrel=wid*QBLK+r32;
  #define CMASK(P0,P1,t) do{int jb_=(t)-(NT-4); if(jb_>=0)cmask(P0,P1,jb_,qrel,hi);}while(0)
  bool resc=false;
  #define START(P0,P1) do{ const float rm=rowmax(P0,P1); resc=false; \
    { const float dl=rm; mhat=fadd_s(mhat,dl); \
      _Pragma("unroll") for(int r=0;r<16;++r){P0[r]=fsub_s(P0[r],dl);P1[r]=fsub_s(P1[r],dl);} \
      _Pragma("unroll") for(int r=0;r<16;++r)negm[r]=-mhat; asm volatile("":"+v"(negm)); } \
    _Pragma("unroll") for(int r=0;r<16;++r)P0[r]=__builtin_amdgcn_exp2f(P0[r]); }while(0)
  #define RESC() do{ if(resc){ asm volatile("s_waitcnt lgkmcnt(0)":::"memory"); \
      _Pragma("unroll") for(int d_=0;d_<2;++d_) _Pragma("unroll") for(int r=0;r<16;++r)o[d_][r]*=wsf[crow(r,hi)]; } }while(0)
  f32x16 pA0,pA1,pB0,pB1;
  #define LDBIAS(C0,C1,t) do{ if(BIAS){ _Pragma("unroll") for(int g_=0;g_<4;++g_){ const f32x4_t b0_=*(const __attribute__((address_space(3))) f32x4_t*)(cb3+64*(t)+8*g_), b1_=*(const __attribute__((address_space(3))) f32x4_t*)(cb3+64*(t)+32+8*g_); \
      C0[4*g_]=b0_[0]+negm[4*g_];C0[4*g_+1]=b0_[1]+negm[4*g_+1];C0[4*g_+2]=b0_[2]+negm[4*g_+2];C0[4*g_+3]=b0_[3]+negm[4*g_+3]; C1[4*g_]=b1_[0]+negm[4*g_];C1[4*g_+1]=b1_[1]+negm[4*g_+1];C1[4*g_+2]=b1_[2]+negm[4*g_+2];C1[4*g_+3]=b1_[3]+negm[4*g_+3]; } } }while(0)
  int sl_prev=0,sl_cur=0,sl_next=SLOTB;
  #define ROT() do{sl_prev=sl_cur;sl_cur=sl_next;sl_next=(sl_next==(NSLOT-1)*SLOTB)?0:sl_next+SLOTB;}while(0)
  DMA_K(2,2*SLOTB);
  WAIT_BAR(3);
  if(BIAS){ LDBIAS(pA0,pA1,0); qkt(pA0,pA1,Kbase,qr,pA0,pA1,r32,hi); } else qkt(pA0,pA1,Kbase,qr,negm,negm,r32,hi);
  asm volatile("s_nop 15\n\ts_nop 7":"+v"(pA0),"+v"(pA1));CMASK(pA0,pA1,0);
  START(pA0,pA1);
  _Pragma("unroll") for(int r=0;r<16;++r)pA1[r]=__builtin_amdgcn_exp2f(pA1[r]);
  WAIT_BAR(0);
  DMA_K(3,0);DMA_V(1,SLOTB);
  ROT();
  kload8(kf,kp0+sl_cur);
  WAIT_BAR(2);
  s16x4 vlo[8],vhi[8]; u32x4 pw0,pw1,pw2,pw3;
  #define PKW(P,B) cvtpk_s(P[B],P[B+1])
  #define PAF(k) __builtin_bit_cast(bf16x8,pw##k)
  #define VFR(i) (bf16x8){vlo[i][0],vlo[i][1],vlo[i][2],vlo[i][3],vhi[i][0],vhi[i][1],vhi[i][2],vhi[i][3]}
  #define PIN(x) asm volatile("":"+v"(x))
  #define MX3(a,b,c) __builtin_fmaxf(__builtin_fmaxf((a),(b)),(c))
  #define GAPA(MF,A0,A1,A2,A3,W0,W1,PW) do{ MF; sacc+=A0; sacc+=A1; sacc+=A2; sacc+=A3; PIN(sacc); W0; W1; PIN(PW); SBAR(); }while(0)
  #define EX(v) __builtin_amdgcn_exp2f(v)
  #define GAPB(MF,X,B) do{ MF; X[B]=EX(X[B]); X[B+1]=EX(X[B+1]); X[B+2]=EX(X[B+2]); X[B+3]=EX(X[B+3]); PIN(X); SBAR(); }while(0)
  #define VRD(i) do{ vlo[i]=vtr(vp_+(((i)>>2)*4096+((i)&3)*1024)); vhi[i]=vtr(vp_+(((i)>>2)*4096+((i)&3)*1024+512)); }while(0)
  #define KRD(G,j) do{ if(G){ kload2(kf,kp0+sl_next,j); SBAR(); } }while(0)
  #define STEP(C0,C1,P0,P1,t,GK,GV,GL) do{ SBAR(); \
    LDBIAS(C0,C1,t); SBAR(); \
    const lds_cptr vp_=vp0+sl_prev; \
    VRD(0); SBAR(); float sacc=(P0[0]+P0[1]); \
    GAPA(C0=__builtin_amdgcn_mfma_f32_32x32x16_bf16(kf[0],qr[0],(BIAS?C0:negm),0,0,0), P0[2],P0[3],P0[4],P0[5],     pw0[0]=PKW(P0,0), pw0[1]=PKW(P0,2), pw0); \
    VRD(4); SBAR(); GAPA(C1=__builtin_amdgcn_mfma_f32_32x32x16_bf16(kf[1],qr[0],(BIAS?C1:negm),0,0,0), P0[6],P0[7],P0[8],P0[9],     pw0[2]=PKW(P0,4), pw0[3]=PKW(P0,6), pw0); \
    VRD(1); SBAR(); GAPA(C0=__builtin_amdgcn_mfma_f32_32x32x16_bf16(kf[2],qr[1],C0,0,0,0),   P0[10],P0[11],P0[12],P0[13], pw1[0]=PKW(P0,8), pw1[1]=PKW(P0,10), pw1); \
    VRD(5); SBAR(); GAPA(C1=__builtin_amdgcn_mfma_f32_32x32x16_bf16(kf[3],qr[1],C1,0,0,0),   P0[14],P0[15],P1[0],P1[1],   pw1[2]=PKW(P0,12),pw1[3]=PKW(P0,14), pw1); \
    VRD(2); SBAR(); GAPA(C0=__builtin_amdgcn_mfma_f32_32x32x16_bf16(kf[4],qr[2],C0,0,0,0),   P1[2],P1[3],P1[4],P1[5],     pw2[0]=PKW(P1,0), pw2[1]=PKW(P1,2), pw2); \
    VRD(6); SBAR(); GAPA(C1=__builtin_amdgcn_mfma_f32_32x32x16_bf16(kf[5],qr[2],C1,0,0,0),   P1[6],P1[7],P1[8],P1[9],     pw2[2]=PKW(P1,4), pw2[3]=PKW(P1,6), pw2); \
    VRD(3); SBAR(); GAPA(C0=__builtin_amdgcn_mfma_f32_32x32x16_bf16(kf[6],qr[3],C0,0,0,0),   P1[10],P1[11],P1[12],P1[13], pw3[0]=PKW(P1,8), pw3[1]=PKW(P1,10), pw3); \
    VRD(7); SBAR(); GAPA(C1=__builtin_amdgcn_mfma_f32_32x32x16_bf16(kf[7],qr[3],C1,0,0,0),   P1[14],P1[15],0.f,0.f,       pw3[2]=PKW(P1,12),pw3[3]=PKW(P1,14), pw3); \
    l_reg+=sacc; \
    if(GK){DMA_K((t)+3,sl_cur);} if(GV){DMA_V((t)+1,sl_next);} \
    CMASK(C0,C1,t); \
    { float a=MX3(C0[0],C0[1],C1[0]),b=MX3(C0[2],C0[3],C1[1]); a=MX3(a,C1[2],C1[3]); \
      _Pragma("unroll") for(int r=4;r<16;r+=4){a=MX3(a,C0[r],C0[r+1]);b=MX3(b,C0[r+2],C0[r+3]);a=MX3(a,C1[r],C1[r+1]);b=MX3(b,C1[r+2],C1[r+3]);} \
      float rm=__builtin_fmaxf(a,b); { auto rr=__builtin_amdgcn_permlane32_swap(__float_as_uint(rm),__float_as_uint(rm),false,false); rm=__builtin_fmaxf(__uint_as_float(rr[0]),__uint_as_float(rr[1])); } \
      resc=false; \
      if(__builtin_expect(__any(rm>(float)THRL),0)){ const float dl=__builtin_fmaxf(rm,0.f); mhat+=dl; \
        _Pragma("unroll") for(int r=0;r<16;++r){C0[r]-=dl;C1[r]-=dl;} \
        _Pragma("unroll") for(int r=0;r<16;++r)negm[r]=-mhat; asm volatile("":"+v"(negm)); \
        const float f=__builtin_amdgcn_exp2f(-dl); l_reg*=f; if(hi==0)wsf[r32]=f; resc=true; } } \
    SBAR(); \
    GAPB(o[0]=__builtin_amdgcn_mfma_f32_32x32x16_bf16(PAF(0),VFR(0),o[0],0,0,0), C0,0); \
    GAPB(o[1]=__builtin_amdgcn_mfma_f32_32x32x16_bf16(PAF(0),VFR(4),o[1],0,0,0), C0,4); \
    KRD(GL,0); GAPB(o[0]=__builtin_amdgcn_mfma_f32_32x32x16_bf16(PAF(1),VFR(1),o[0],0,0,0), C0,8); \
    KRD(GL,1); GAPB(o[1]=__builtin_amdgcn_mfma_f32_32x32x16_bf16(PAF(1),VFR(5),o[1],0,0,0), C0,12); \
    KRD(GL,2); GAPB(o[0]=__builtin_amdgcn_mfma_f32_32x32x16_bf16(PAF(2),VFR(2),o[0],0,0,0), C1,0); \
    KRD(GL,3); GAPB(o[1]=__builtin_amdgcn_mfma_f32_32x32x16_bf16(PAF(2),VFR(6),o[1],0,0,0), C1,4); \
    GAPB(o[0]=__builtin_amdgcn_mfma_f32_32x32x16_bf16(PAF(3),VFR(3),o[0],0,0,0), C1,8); \
    GAPB(o[1]=__builtin_amdgcn_mfma_f32_32x32x16_bf16(PAF(3),VFR(7),o[1],0,0,0), C1,12); \
    }while(0)
  int t=1;
  #undef CMASK
  #define CMASK(P0,P1,t) do{}while(0)
  for(;t+5<NT;t+=2){
    STEP(pB0,pB1,pA0,pA1,t,true,true,true);     WAIT_BAR(2); RESC(); ROT();
    STEP(pA0,pA1,pB0,pB1,t+1,true,true,true);   WAIT_BAR(2); RESC(); ROT();
  }
  #undef CMASK
  #define CMASK(P0,P1,t) do{int jb_=(t)-(NT-4); if(jb_>=0)cmask(P0,P1,jb_,qrel,hi);}while(0)
  #define ENDW(tt) do{ if((tt)+3<NT){WAIT_BAR(2);} else if((tt)+2<NT){WAIT_BAR(1);} else {WAIT_BAR(0);} }while(0)
  for(;t+1<NT;t+=2){
    STEP(pB0,pB1,pA0,pA1,t,(t+3<NT),(t+1<NT),(t+1<NT));       ENDW(t);   RESC(); ROT();
    STEP(pA0,pA1,pB0,pB1,t+1,(t+4<NT),(t+2<NT),(t+2<NT));     ENDW(t+1); RESC(); ROT();
  }
  STEP(pB0,pB1,pA0,pA1,NT-1,false,false,false); RESC();
  { float sacc=pB0[0]+pB0[1]; _Pragma("unroll") for(int r=2;r<16;++r)sacc+=pB0[r]; _Pragma("unroll") for(int r=0;r<16;++r)sacc+=pB1[r]; l_reg+=sacc;
    pw0=(u32x4){PKW(pB0,0),PKW(pB0,2),PKW(pB0,4),PKW(pB0,6)};pw1=(u32x4){PKW(pB0,8),PKW(pB0,10),PKW(pB0,12),PKW(pB0,14)};pw2=(u32x4){PKW(pB1,0),PKW(pB1,2),PKW(pB1,4),PKW(pB1,6)};pw3=(u32x4){PKW(pB1,8),PKW(pB1,10),PKW(pB1,12),PKW(pB1,14)};
    SBAR(); pv(o,vb0+sl_cur,PAF(0),PAF(1),PAF(2),PAF(3)); }
  #undef PKW
  #undef PAF
  #undef VFR
  #undef PIN
  #undef MX3
  #undef GAPA
  #undef GAPB
  #undef EX
  #undef VRD
  #undef KRD
  #undef STEP
  #undef ENDW
  {auto rr=__builtin_amdgcn_permlane32_swap(__float_as_uint(l_reg),__float_as_uint(l_reg),false,false);l_reg=__uint_as_float(rr[0])+__uint_as_float(rr[1]);}
  if(hi==0)wsf[32+r32]=l_reg;asm volatile("s_waitcnt lgkmcnt(0)":::"memory");
  float rli[16];
  #pragma unroll
  for(int r=0;r<16;++r)rli[r]=__builtin_amdgcn_rcpf(wsf[32+crow(r,hi)]);
  bf16*Ow=Oh+(rowbase+q0+wid*QBLK)*(long)op;
  { bf16*stg=(bf16*)(shm+LDS_OST)+wid*2048;
    #pragma unroll
    for(int r=0;r<16;++r){const int orow=crow(r,hi);
      #pragma unroll
      for(int d0=0;d0<2;++d0)stg[orow*64+d0*32+r32]=__float2bfloat16(o[d0][r]*rli[r]);}
    asm volatile("s_waitcnt lgkmcnt(0)":::"memory");
    #pragma unroll
    for(int i=0;i<4;++i){const int row=i*8+(lane>>3),ch=lane&7; const u32x4 v=*(const u32x4*)(stg+row*64+ch*8); ATTN_STORE16(Ow+(long)row*op+ch*8,v);} }
  asm volatile("s_waitcnt lgkmcnt(0)\n\ts_barrier":::"memory");
  #undef DMA_K
  #undef DMA_V
  #undef CMASK
  #undef START
  #undef RESC
  #undef ROT
  #undef LDBIAS
}
constexpr int ATTN_LDS_BYTES=LDS_BYTES;
#undef SBAR
#undef WAIT_BAR
}

constexpr int BATCH = 8, SEQ = 2048, DM = 1024, M_TOK = BATCH * SEQ, DEPTH = 4;
constexpr int D_IN = 6664, C_FF = 3584, C_GL = 3592;
constexpr int PP = 3584;
constexpr int NGL = 3072;
constexpr float ALPHA = 1.681792830507429f;
constexpr float LN_EPS = 1e-5f, RMS_EPS = 1e-6f;
constexpr float LOG2E = 1.4426950408889634f;
constexpr float C2 = 0.125f * LOG2E;

typedef unsigned short bf16;
typedef unsigned v4u __attribute__((ext_vector_type(4)));
typedef float f32x4 __attribute__((ext_vector_type(4)));
#define LAS __attribute__((address_space(3)))
#define LDS_WAIT() asm volatile("s_waitcnt lgkmcnt(0)" ::: "memory")
__device__ __forceinline__ unsigned f2bf(float f) { unsigned u = __builtin_bit_cast(unsigned, f); return (u + 0x7fffu + ((u >> 16) & 1u)) >> 16; }
__device__ __forceinline__ unsigned pk2(float lo, float hi) { return f2bf(lo) | (f2bf(hi) << 16); }
__device__ __forceinline__ float bf2f(bf16 v) { return __builtin_bit_cast(float, (unsigned)v << 16); }
__device__ __forceinline__ float wave_sum(float v) {
#define WS_DPP(ctrl) v += __builtin_bit_cast(float, __builtin_amdgcn_update_dpp(0, __builtin_bit_cast(int, v), ctrl, 0xf, 0xf, true))
    WS_DPP(0xB1); WS_DPP(0x4E); WS_DPP(0x141); WS_DPP(0x140);
#undef WS_DPP
    v += __builtin_bit_cast(float, __builtin_amdgcn_ds_swizzle(__builtin_bit_cast(int, v), 0x401F));
    return __builtin_bit_cast(float, __builtin_amdgcn_readlane(__builtin_bit_cast(int, v), 0)) + __builtin_bit_cast(float, __builtin_amdgcn_readlane(__builtin_bit_cast(int, v), 32));
}
__device__ __forceinline__ float wave_max(float v) {
#pragma unroll
    for (int o = 1; o < 64; o <<= 1) v = fmaxf(v, __shfl_xor(v, o));
    return v;
}
__device__ __forceinline__ float sigmoidf_(float z) { return 1.f / (1.f + __expf(-z)); }
__device__ __forceinline__ float gelu_tanh(float y) { const float u = 0.7978845608028654f * (y + 0.044715f * y * y * y); return 0.5f * y * (1.f + tanhf(u)); }

constexpr size_t MiB = 1u << 20;
constexpr size_t WS_CTL = 0;
constexpr size_t WS_WIN = 1 * MiB;
constexpr size_t WS_WB = 14 * MiB;
constexpr size_t WS_WO = 17 * MiB;
constexpr size_t WS_WGLU = 19 * MiB;
constexpr size_t WS_WG = 20 * MiB;
constexpr size_t WS_WU = 28 * MiB;
constexpr size_t WS_WD = 36 * MiB;
constexpr size_t WS_ROPE = 44 * MiB;
constexpr size_t WS_XB = 45 * MiB;
constexpr size_t WS_PROJ = 77 * MiB;
constexpr size_t WS_GL = 189 * MiB;
constexpr size_t WS_GY = 285 * MiB;
constexpr size_t WS_BR = 301 * MiB;
constexpr size_t WS_OD = 349 * MiB;
constexpr size_t WS_CB = 381 * MiB;
constexpr size_t WS_LOGF = 382 * MiB;
constexpr size_t WS_ROUTE = 383 * MiB;
constexpr size_t WS_TOKL = 384 * MiB;
constexpr size_t WS_WL = 385 * MiB;
constexpr size_t WS_TSLOT = 386 * MiB;
constexpr size_t WS_SMT = 387 * MiB;
constexpr size_t WS_SW2 = 391 * MiB;
constexpr size_t WS_SW3 = 393 * MiB;
constexpr size_t WS_SAL = 395 * MiB;
constexpr size_t WS_END = 396 * MiB;
constexpr size_t WS_P = WS_PROJ;
constexpr size_t WS_MG = WS_PROJ;
constexpr size_t WS_MIX = WS_GL;
constexpr size_t WS_HG = WS_PROJ;
constexpr size_t WS_HU = WS_PROJ + 32 * MiB;
constexpr size_t WS_FF = WS_GL;
constexpr size_t WS_H = WS_GY;
constexpr size_t WS_Y = WS_PROJ;

template <class Epi> __global__ void __launch_bounds__(512, 2) gemm_kernel(pg8::Gemm g, Epi E) {
    extern __shared__ __attribute__((aligned(16))) unsigned char lds[];
    pg8::StaticOrder S; S.init(g.M, g.N, (int)gridDim.x, (int)blockIdx.x);
    pg8::gemm_phase<Epi, pg8::StaticOrder, true, true>((PG8_LAS unsigned char*)lds, g, S, E);
}

__global__ void k_cast_bf16(const float* __restrict__ x, bf16* __restrict__ o, size_t n4) {
    for (size_t i = (size_t)blockIdx.x * blockDim.x + threadIdx.x; i < n4; i += (size_t)gridDim.x * blockDim.x) {
        const f32x4 v = ((const f32x4*)x)[i]; uint2 w; w.x = pk2(v.x, v.y); w.y = pk2(v.z, v.w); ((uint2*)o)[i] = w; }
}
__global__ void k_ropetab(float* tab) {
    const int idx = blockIdx.x * blockDim.x + threadIdx.x; if (idx >= SEQ * 32) return;
    const int s = idx >> 5, i = idx & 31;
    const float inv_freq = exp2f(-(float)(2 * i) * (13.287712379549449f / 64.0f));
    const float ang = (float)s * inv_freq;
    const double rev = (double)ang * 0.15915494309189535; const double fr = rev - __builtin_floor(rev + 0.5);
    const float a = (float)(fr * 6.283185307179586);
    tab[idx] = cosf(a); tab[SEQ * 32 + idx] = sinf(a);
}
__global__ void k_rope(bf16* __restrict__ P, const float* __restrict__ tab) {
    const size_t idx = (size_t)blockIdx.x * blockDim.x + threadIdx.x; if (idx >= (size_t)M_TOK * 16 * 32) return;
    const int d = idx & 31, hh = (idx >> 5) & 15; const size_t t = idx >> 9; const int s = (int)(t % SEQ);
    bf16* p = P + t * PP + 512 + hh * 64 + d;
    const float t1 = bf2f(p[0]), t2 = bf2f(p[32]), cs = tab[s * 32 + d], sn = tab[SEQ * 32 + s * 32 + d];
    p[0] = (bf16)f2bf(t1 * cs - t2 * sn); p[32] = (bf16)f2bf(t2 * cs + t1 * sn);
}
__global__ void __launch_bounds__(256) k_fgate(const float* __restrict__ x, const float* __restrict__ w_in, const float* __restrict__ fbias, float* __restrict__ logf) {
    const int lane = threadIdx.x & 63, gw = blockIdx.x * 4 + (threadIdx.x >> 6), NGW = gridDim.x * 4;
    for (int t = gw; t < M_TOK; t += NGW) {
        float acc[8];
#pragma unroll
        for (int h = 0; h < 8; ++h) acc[h] = 0.f;
#pragma unroll
        for (int j = 0; j < 4; ++j) { const int k0 = 4 * lane + 256 * j; const f32x4 xv = *(const f32x4*)(x + (size_t)t * DM + k0);
#pragma unroll
            for (int c = 0; c < 4; ++c) { const float* wr = w_in + (size_t)(k0 + c) * D_IN + C_FF; const f32x4 w0 = *(const f32x4*)wr, w1 = *(const f32x4*)(wr + 4); const float xs = xv[c];
                acc[0] += xs * w0.x; acc[1] += xs * w0.y; acc[2] += xs * w0.z; acc[3] += xs * w0.w; acc[4] += xs * w1.x; acc[5] += xs * w1.y; acc[6] += xs * w1.z; acc[7] += xs * w1.w; } }
        const int b = t / SEQ, s = t % SEQ;
#pragma unroll
        for (int h = 0; h < 8; ++h) { const float z = wave_sum(acc[h]) + fbias[h]; const float ls = fminf(z, 0.f) - log1pf(__expf(-fabsf(z)));
            if (lane == h) logf[((size_t)(b * 8 + h)) * SEQ + s] = ls; }
    }
}
__global__ void __launch_bounds__(64) k_cumsum(const float* __restrict__ logf, float* __restrict__ cb) {
    const int lane = threadIdx.x; const size_t base = (size_t)blockIdx.x * SEQ + lane * 32;
    float v[32]; float run = 0.f;
#pragma unroll
    for (int i = 0; i < 32; ++i) { run += logf[base + i]; v[i] = run; }
    float incl = run;
#pragma unroll
    for (int o = 1; o < 64; o <<= 1) { const float n = __shfl_up(incl, o); if (lane >= o) incl += n; }
    const float off = incl - run;
#pragma unroll
    for (int i = 0; i < 32; ++i) cb[base + i] = v[i] + off;
}
__global__ void __launch_bounds__(64) k_ssm(const bf16* __restrict__ PROJ, const float* __restrict__ lam_re, const float* __restrict__ lam_im, const float* __restrict__ log_dt,
                                              const float* __restrict__ b_re, const float* __restrict__ b_im, const float* __restrict__ c_re, const float* __restrict__ c_im,
                                              const float* __restrict__ dsk, bf16* __restrict__ GY) {
    const int p = threadIdx.x, b = blockIdx.x >> 5, g = blockIdx.x & 31;
    const float lr = lam_re[g * 64 + p], li = lam_im[g * 64 + p], dt = expf(log_dt[g]);
    const float mag = expf(lr * dt), ang = li * dt, ar = mag * cosf(ang), ai = mag * sinf(ang);
    const float er = ar - 1.f, ei = ai, den = lr * lr + li * li, qr = (er * lr + ei * li) / den, qi = (ei * lr - er * li) / den;
    float bbr[16], bbi[16], cr[16], ci[16];
#pragma unroll
    for (int n = 0; n < 16; ++n) { const float br = b_re[(g * 64 + p) * 16 + n], bi = b_im[(g * 64 + p) * 16 + n]; bbr[n] = qr * br - qi * bi; bbi[n] = qr * bi + qi * br;
        cr[n] = c_re[(g * 16 + n) * 64 + p]; ci[n] = c_im[(g * 16 + n) * 64 + p]; }
    const float dn = dsk[g * 16 + (p & 15)];
    float xr = 0.f, xi = 0.f;
    const bf16* up = PROJ + (size_t)b * SEQ * PP + g * 16;
    for (int s = 0; s < SEQ; ++s) {
        const v4u u0 = *(const v4u*)(up + (size_t)s * PP), u1 = *(const v4u*)(up + (size_t)s * PP + 8);
        float u[16];
        u[0] = __builtin_bit_cast(float, u0.x << 16); u[1] = __builtin_bit_cast(float, u0.x & 0xffff0000u); u[2] = __builtin_bit_cast(float, u0.y << 16); u[3] = __builtin_bit_cast(float, u0.y & 0xffff0000u);
        u[4] = __builtin_bit_cast(float, u0.z << 16); u[5] = __builtin_bit_cast(float, u0.z & 0xffff0000u); u[6] = __builtin_bit_cast(float, u0.w << 16); u[7] = __builtin_bit_cast(float, u0.w & 0xffff0000u);
        u[8] = __builtin_bit_cast(float, u1.x << 16); u[9] = __builtin_bit_cast(float, u1.x & 0xffff0000u); u[10] = __builtin_bit_cast(float, u1.y << 16); u[11] = __builtin_bit_cast(float, u1.y & 0xffff0000u);
        u[12] = __builtin_bit_cast(float, u1.z << 16); u[13] = __builtin_bit_cast(float, u1.z & 0xffff0000u); u[14] = __builtin_bit_cast(float, u1.w << 16); u[15] = __builtin_bit_cast(float, u1.w & 0xffff0000u);
        float bur = 0.f, bui = 0.f;
#pragma unroll
        for (int n = 0; n < 16; ++n) { bur += bbr[n] * u[n]; bui += bbi[n] * u[n]; }
        const float nxr = ar * xr - ai * xi + bur, nxi = ar * xi + ai * xr + bui; xr = nxr; xi = nxi;
        float mine = 0.f, un = 0.f;
#pragma unroll
        for (int n = 0; n < 16; ++n) { const float y = wave_sum(cr[n] * xr - ci[n] * xi); if ((p & 15) == n) { mine = y; un = u[n]; } }
        if (p < 16) GY[((size_t)b * SEQ + s) * 512 + g * 16 + p] = (bf16)f2bf(gelu_tanh(mine + dn * un));
    }
}
__global__ void k_glu(const bf16* __restrict__ Z, bf16* __restrict__ YS) {
    const size_t idx = (size_t)blockIdx.x * blockDim.x + threadIdx.x; if (idx >= (size_t)M_TOK * 512) return;
    const size_t t = idx >> 9; const int j = idx & 511;
    const float v = bf2f(Z[t * 1024 + j]), gt = bf2f(Z[t * 1024 + 512 + j]);
    YS[idx] = (bf16)f2bf(v * sigmoidf_(gt));
}
struct AttnArgs { const bf16* Q; const bf16* K; const bf16* V; const float* CB; bf16* O; int qpitch, qcol0, kpitch, kcol0, vpitch, vcol0, vhstride, vdiv, opitch, ocol0, ohstride, ocstride, nheads, pad; float qscale, pad2; };
template <int VD> __global__ void __launch_bounds__(256) k_attn(AttnArgs a) {
    __shared__ float sc[4][SEQ];
    const int lane = threadIdx.x & 63, w = threadIdx.x >> 6;
    int bid = blockIdx.x; const int ig = bid % (SEQ / 4); bid /= (SEQ / 4); const int h = bid % a.nheads, b = bid / a.nheads;
    const int i = ig * 4 + w; const size_t t0 = (size_t)b * SEQ;
    float q[64];
    { const bf16* qp = a.Q + (t0 + i) * a.qpitch + a.qcol0 + h * 64;
#pragma unroll
      for (int d = 0; d < 64; ++d) q[d] = bf2f(qp[d]) * a.qscale; }
    const float* cbp = a.CB ? a.CB + (size_t)(b * a.nheads + h) * SEQ : nullptr;
    const float cq = cbp ? cbp[i] : 0.f;
    float m = -INFINITY;
    for (int j = lane; j <= i; j += 64) {
        const bf16* kp = a.K + (t0 + j) * a.kpitch + a.kcol0 + h * 64; float s = 0.f;
#pragma unroll
        for (int c = 0; c < 8; ++c) { const v4u kv = *(const v4u*)(kp + 8 * c);
            s += q[8 * c + 0] * __builtin_bit_cast(float, kv.x << 16) + q[8 * c + 1] * __builtin_bit_cast(float, kv.x & 0xffff0000u) + q[8 * c + 2] * __builtin_bit_cast(float, kv.y << 16) + q[8 * c + 3] * __builtin_bit_cast(float, kv.y & 0xffff0000u)
               + q[8 * c + 4] * __builtin_bit_cast(float, kv.z << 16) + q[8 * c + 5] * __builtin_bit_cast(float, kv.z & 0xffff0000u) + q[8 * c + 6] * __builtin_bit_cast(float, kv.w << 16) + q[8 * c + 7] * __builtin_bit_cast(float, kv.w & 0xffff0000u); }
        if (cbp) s += (cq - cbp[j]) * LOG2E;
        sc[w][j] = s; m = fmaxf(m, s);
    }
    m = wave_max(m);
    __syncthreads();
    float l = 0.f;
    for (int j = lane; j <= i; j += 64) { const float p = exp2f(sc[w][j] - m); sc[w][j] = p; l += p; }
    l = wave_sum(l);
    __syncthreads();
    const int vh = h / a.vdiv, vc = h % a.vdiv;
    const bf16* vp = a.V + t0 * a.vpitch + a.vcol0 + vh * a.vhstride + lane;
    float o0 = 0.f, o1 = 0.f;
    for (int j = 0; j <= i; ++j) { const float p = sc[w][j]; o0 += p * bf2f(vp[(size_t)j * a.vpitch]); if (VD == 128) o1 += p * bf2f(vp[(size_t)j * a.vpitch + 64]); }
    bf16* op = a.O + (t0 + i) * a.opitch + a.ocol0 + vh * a.ohstride + vc * a.ocstride + lane;
    const float rl = 1.f / l;
    op[0] = (bf16)f2bf(o0 * rl); if (VD == 128) op[64] = (bf16)f2bf(o1 * rl);
}
__global__ void __launch_bounds__(256) k_diffcombine(const bf16* __restrict__ OD, const float* __restrict__ lam, const float* __restrict__ gnorm, float lam_init, bf16* __restrict__ YD) {
    const int lane = threadIdx.x & 63, gw = blockIdx.x * 4 + (threadIdx.x >> 6);
    if (gw >= M_TOK * 4) return;
    const int t = gw >> 2, h = gw & 3;
    const float s01 = wave_sum(lam[lane] * lam[64 + lane]), s23 = wave_sum(lam[128 + lane] * lam[192 + lane]);
    const float lam_full = expf(s01) - expf(s23) + lam_init;
    const bf16* o0 = OD + (size_t)t * 1024 + h * 128, *o1 = o0 + 512;
    const float a0 = bf2f(o0[lane]) - lam_full * bf2f(o1[lane]), a1 = bf2f(o0[lane + 64]) - lam_full * bf2f(o1[lane + 64]);
    const float ss = wave_sum(a0 * a0 + a1 * a1);
    const float r = rsqrtf(ss * (1.f / 128.f) + RMS_EPS) * (1.f - lam_init);
    YD[(size_t)t * 512 + h * 128 + lane] = (bf16)f2bf(a0 * r * gnorm[h * 128 + lane]);
    YD[(size_t)t * 512 + h * 128 + lane + 64] = (bf16)f2bf(a1 * r * gnorm[h * 128 + lane + 64]);
}
__global__ void k_merge(const bf16* __restrict__ GL, const bf16* __restrict__ P, bf16* __restrict__ MG) {
    const size_t idx = (size_t)blockIdx.x * blockDim.x + threadIdx.x; if (idx >= (size_t)M_TOK * DM) return;
    const size_t t = idx >> 10; const int d = idx & 1023; float acc = 0.f;
#pragma unroll
    for (int n = 0; n < 3; ++n) acc += bf2f(GL[t * NGL + n * 1024 + d]) * bf2f(P[(size_t)n * M_TOK * DM + idx]);
    MG[idx] = (bf16)f2bf(acc);
}
__device__ __forceinline__ void ln_rows(const float* xin, const float* __restrict__ add, const float* __restrict__ g, const float* __restrict__ bta, float* xo, bf16* __restrict__ xb,
                                             const float* __restrict__ w_g, const float* __restrict__ b_g, const float* __restrict__ w_e, const float* __restrict__ b_e, float* __restrict__ gate, int gw, int NGW, int lane) {
    for (int t = gw; t < M_TOK; t += NGW) {
        f32x4 v[4]; float s = 0.f;
#pragma unroll
        for (int j = 0; j < 4; ++j) { const size_t o = (size_t)t * DM + 4 * lane + 256 * j; v[j] = ALPHA * *(const f32x4*)(xin + o) + *(const f32x4*)(add + o); s += (v[j].x + v[j].y) + (v[j].z + v[j].w); }
        const float mean = wave_sum(s) * (1.f / DM); float s2 = 0.f;
#pragma unroll
        for (int j = 0; j < 4; ++j) { v[j] = v[j] - mean; s2 += (v[j].x * v[j].x + v[j].y * v[j].y) + (v[j].z * v[j].z + v[j].w * v[j].w); }
        const float rstd = rsqrtf(wave_sum(s2) * (1.f / DM) + LN_EPS);
#pragma unroll
        for (int j = 0; j < 4; ++j) { const int c = 4 * lane + 256 * j; const size_t o = (size_t)t * DM + c; v[j] = v[j] * rstd * *(const f32x4*)(g + c) + *(const f32x4*)(bta + c);
            *(f32x4*)(xo + o) = v[j]; uint2 w; w.x = pk2(v[j].x, v[j].y); w.y = pk2(v[j].z, v[j].w); *(uint2*)(xb + o) = w; }
        if (gate) {
            float lg[4], le[16];
#pragma unroll
            for (int q = 0; q < 4; ++q) lg[q] = 0.f;
#pragma unroll
            for (int q = 0; q < 16; ++q) le[q] = 0.f;
#pragma unroll
            for (int j = 0; j < 4; ++j)
#pragma unroll
                for (int c = 0; c < 4; ++c) { const int k = 4 * lane + 256 * j + c; const float xs = v[j][c]; const f32x4 wg = *(const f32x4*)(w_g + (size_t)k * 4);
                    lg[0] += xs * wg.x; lg[1] += xs * wg.y; lg[2] += xs * wg.z; lg[3] += xs * wg.w;
#pragma unroll
                    for (int q = 0; q < 4; ++q) { const f32x4 we = *(const f32x4*)(w_e + (size_t)k * 16 + 4 * q); le[4 * q] += xs * we.x; le[4 * q + 1] += xs * we.y; le[4 * q + 2] += xs * we.z; le[4 * q + 3] += xs * we.w; } }
#pragma unroll
            for (int q = 0; q < 4; ++q) lg[q] = wave_sum(lg[q]) + b_g[q];
#pragma unroll
            for (int q = 0; q < 16; ++q) le[q] = wave_sum(le[q]) + b_e[q];
            int gi = 0; float gm = lg[0];
#pragma unroll
            for (int q = 1; q < 4; ++q) if (lg[q] > gm) { gm = lg[q]; gi = q; }
            float den = 0.f;
#pragma unroll
            for (int q = 0; q < 4; ++q) den += __expf(lg[q] - gm);
            const float gp = 1.f / den;
            float sel[4];
#pragma unroll
            for (int q = 0; q < 4; ++q) sel[q] = gi == 0 ? le[q] : gi == 1 ? le[4 + q] : gi == 2 ? le[8 + q] : le[12 + q];
            int i0 = 0; float v0 = sel[0];
#pragma unroll
            for (int q = 1; q < 4; ++q) if (sel[q] > v0) { v0 = sel[q]; i0 = q; }
            int i1 = -1; float v1 = -INFINITY;
#pragma unroll
            for (int q = 0; q < 4; ++q) if (q != i0 && sel[q] > v1) { v1 = sel[q]; i1 = q; }
            const float e1 = __expf(v1 - v0), w0 = gp / (1.f + e1), w1 = gp * e1 / (1.f + e1);
            const int E0 = gi * 4 + i0, E1 = gi * 4 + i1;
            if (lane < 16) gate[(size_t)t * 16 + lane] = (lane == E0 ? w0 : 0.f) + (lane == E1 ? w1 : 0.f);
        }
    }
}
__global__ void __launch_bounds__(256) k_ln(const float* xin, const float* __restrict__ add, const float* __restrict__ g, const float* __restrict__ bta, float* xo, bf16* __restrict__ xb,
                                             const float* __restrict__ w_g, const float* __restrict__ b_g, const float* __restrict__ w_e, const float* __restrict__ b_e, float* __restrict__ gate) {
    ln_rows(xin, add, g, bta, xo, xb, w_g, b_g, w_e, b_e, gate, blockIdx.x * 4 + (threadIdx.x >> 6), gridDim.x * 4, threadIdx.x & 63);
}
__global__ void k_moe_hidden(bf16* __restrict__ HG, const bf16* __restrict__ HU, const float* __restrict__ gate, int r0) {
    const size_t idx = (size_t)blockIdx.x * blockDim.x + threadIdx.x; if (idx >= (size_t)4096 * 4096) return;
    const int r = (int)(idx >> 12), c = (int)(idx & 4095); const float gt = gate[(size_t)(r0 + r) * 16 + (c >> 8)];
    float hv = 0.f;
    if (gt != 0.f) { const float a = bf2f(HG[idx]), u = bf2f(HU[idx]); hv = a * sigmoidf_(a) * u * gt; }
    HG[idx] = (bf16)f2bf(hv);
}


typedef __attribute__((address_space(1))) unsigned gu32;
#define RLX_AGENT __ATOMIC_RELAXED, __HIP_MEMORY_SCOPE_AGENT
constexpr int NWAVES = 8;
constexpr int RING_BYTES = 139264;
constexpr int MISC_OFF = RING_BYTES;
constexpr int LDS_BYTES = RING_BYTES + 2048;
constexpr int CW_CNT = 8192;
constexpr int CW_BAR = 4096;
constexpr int MAX_BAR_REGIONS = 64;
constexpr size_t CTL_ZERO_BYTES = 1 * MiB;
#define XB_TMO      128
#define XB_XCNT(j)  (256  + 64 * (j))
#define XB_XSUB(j)  (1280 + 64 * (j))
#define XB_XGEN(j)  (2304 + 64 * (j))
#define XB_TOP      3328
#define XB_TOPGEN   3392
#define XCD_BAR_WORDS 3456
#define XB_SPIN_CAP (1u << 24)

__device__ __forceinline__ unsigned xb_ld(unsigned* p)              { return __hip_atomic_load(p, __ATOMIC_RELAXED, __HIP_MEMORY_SCOPE_AGENT); }
__device__ __forceinline__ unsigned xb_add(unsigned* p, unsigned v) { return __hip_atomic_fetch_add(p, v, __ATOMIC_RELAXED, __HIP_MEMORY_SCOPE_AGENT); }
__device__ __forceinline__ unsigned xb_xcc_id() { return (unsigned)__builtin_amdgcn_s_getreg((3 << 11) | 20) & 0xFu; }
#define XB_SPIN(cond, bar) do { unsigned _sp = 0; while (cond) { __builtin_amdgcn_s_sleep(1); \
    if ((++_sp & 255u) == 0u) { if (xb_ld(&(bar)[XB_TMO])) break; if (_sp > XB_SPIN_CAP) { atomicAdd(&(bar)[XB_TMO], 1u); break; } } } } while (0)

struct XcdBarrier {
    unsigned* bar; unsigned x;
    volatile LAS unsigned* st;
};

__device__ __forceinline__ XcdBarrier xcd_barrier_post(unsigned* bar, volatile LAS unsigned* st) {
    XcdBarrier b; b.bar = bar; b.x = xb_xcc_id(); b.st = st;
    if (threadIdx.x == 0) (void)xb_add(&bar[XB_XCNT(b.x)], 1u);
    return b;
}
__device__ __forceinline__ void xcd_barrier_complete(unsigned* bar, unsigned x, unsigned& nloc, unsigned& nx) {
    const unsigned G = gridDim.x * gridDim.y * gridDim.z;
    unsigned sum, cnt, mine, sp = 0u;
    for (;;) {
        sum = 0u; cnt = 0u; mine = 0u;
#pragma unroll 1
        for (unsigned j = 0; j < 16; ++j) { const unsigned c = xb_ld(&bar[XB_XCNT(j)]); sum += c; cnt += (c > 0u) ? 1u : 0u; }
        if (sum == G) { mine = xb_ld(&bar[XB_XCNT(x)]); break; }
        __builtin_amdgcn_s_sleep(1);
        if ((++sp & 255u) == 0u) { if (xb_ld(&bar[XB_TMO])) { mine = xb_ld(&bar[XB_XCNT(x)]); break; } if (sp > XB_SPIN_CAP) { atomicAdd(&bar[XB_TMO], 1u); mine = xb_ld(&bar[XB_XCNT(x)]); break; } }
    }
    nloc = mine > 0u ? mine : 1u; nx = cnt > 0u ? cnt : 1u;
}

__device__ __forceinline__ void xcd_barrier(const XcdBarrier& b) {
    asm volatile("s_waitcnt vmcnt(0)" ::: "memory");
    __syncthreads();
    if (threadIdx.x == 0) {
        unsigned* bar = b.bar; asm volatile("" : "+s"(bar));
        __builtin_amdgcn_s_waitcnt(0);
        unsigned nloc = b.st[0], nx = b.st[1];
        if (nloc == 0u) { xcd_barrier_complete(bar, b.x, nloc, nx); b.st[0] = nloc; b.st[1] = nx; }
        const unsigned old = xb_add(&bar[XB_XSUB(b.x)], 1u);
        const unsigned gen = old / nloc;
        if (old + 1u == (gen + 1u) * nloc) {
            __builtin_amdgcn_fence(__ATOMIC_RELEASE, "agent");
            asm volatile("s_waitcnt vmcnt(0)" ::: "memory");
            const unsigned og = xb_add(&bar[XB_TOP], 1u);
            const unsigned tg = og / nx;
            if (og + 1u == (tg + 1u) * nx) xb_add(&bar[XB_TOPGEN], 1u);
            else XB_SPIN(xb_ld(&bar[XB_TOPGEN]) == tg, bar);
            __builtin_amdgcn_fence(__ATOMIC_ACQUIRE, "agent");
            xb_add(&bar[XB_XGEN(b.x)], 1u);
            asm volatile("s_waitcnt vmcnt(0)" ::: "memory");
        } else {
            XB_SPIN(xb_ld(&bar[XB_XGEN(b.x)]) == gen, bar);
            __builtin_amdgcn_fence(__ATOMIC_ACQUIRE, "agent");
            asm volatile("s_waitcnt vmcnt(0)" ::: "memory");
        }
    }
    __syncthreads();
}

struct ConvJob { const float* src; bf16* dst; long src_lstride, src_bstride, dst_bstride; int K, N, ld_src, col0, nbatch, dst_ld, item0, mode; };
constexpr int MAX_JOBS = 12;
struct ConvArgs { ConvJob j[MAX_JOBS]; int njobs, nitems, nitemsA, pad; };
__device__ __forceinline__ int conv_src_col(int mode, int n) {
    if (mode == 1) { const int p = n & 63; return (n & ~63) + 4 * (p >> 3) + (p & 3) + 32 * ((p >> 2) & 1); }
    if (mode == 2) { const int t = n >> 8, p = n & 255; return 512 * ((p >> 2) & 1) + 128 * t + 4 * (p >> 3) + (p & 3); }
    return n;
}
__device__ __forceinline__ int conv_dst_row(int mode, int n) {
    if (mode == 3 || mode == 4) return 256 * (n >> 7) + 8 * ((n & 127) >> 2) + (n & 3) + (mode == 4 ? 4 : 0);
    return n;
}
#define CAS __attribute__((address_space(4)))
__device__ __forceinline__ void conv_item(const CAS ConvArgs& A, int layer, int it, LAS float* scr, int lane) {
    int js = 0; const int nj = A.njobs;
#pragma unroll 1
    for (int q = 1; q < nj; ++q) if (it >= A.j[q].item0) js = q;
    const CAS ConvJob& J = A.j[js];
    int r = it - J.item0; const int nblk = J.N / 32, per_b = (J.K / 64) * nblk;
    const int bt = r / per_b; r -= bt * per_b; const int kb = r / nblk, nb = r % nblk, k0 = 64 * kb, n0 = 32 * nb;
    const float* W = J.src + (size_t)layer * J.src_lstride + (size_t)bt * J.src_bstride + J.col0 + conv_src_col(J.mode, n0 + (lane & 31)); bf16* WT = J.dst + (size_t)bt * J.dst_bstride;
    const int ld = J.ld_src, dld = J.dst_ld;
#pragma unroll 8
    for (int i = 0; i < 32; ++i) { const int kk = 2 * i + (lane >> 5); scr[kk * 33 + (lane & 31)] = W[(size_t)(k0 + kk) * ld]; }
    LDS_WAIT(); asm volatile("" ::: "memory");
    const int c = lane & 7;
#pragma unroll
    for (int jj = 0; jj < 4; ++jj) { const int n = (lane >> 3) + 8 * jj; const LAS float* s = scr + (8 * c) * 33 + n;
        v4u o; o.x = pk2(s[0 * 33], s[1 * 33]); o.y = pk2(s[2 * 33], s[3 * 33]); o.z = pk2(s[4 * 33], s[5 * 33]); o.w = pk2(s[6 * 33], s[7 * 33]);
        *(v4u*)(WT + (size_t)conv_dst_row(J.mode, n0 + n) * dld + k0 + 8 * c) = o; }
    LDS_WAIT(); asm volatile("" ::: "memory");
}

__device__ __forceinline__ int opq_s(int x) { asm volatile("" : "+s"(x)); return x; }
struct MkArgs {
    const float* in[27]; float* out; unsigned char* ws;
    int layer_lo, layer_hi, ph_lo, ph_hi, bar_region, pad;
    float lam_init[4];
    int rep[12];
    ConvArgs conv;
};
constexpr int NPH = 11;
__device__ __forceinline__ void fox_bias_scan(LAS float* cb, LAS float* wtot, const float* logf_row, int n) {
    int tid = threadIdx.x; asm volatile("" : "+v"(tid)); const int lane = tid & 63, wave = __builtin_amdgcn_readfirstlane(tid >> 6);
    float z_ = 0.f; asm volatile("" : "+v"(z_)); f32x4 v = (f32x4){z_, z_, z_, z_}; if (4 * tid < n) v = *(const f32x4*)(logf_row + 4 * tid);
    v.y += v.x; v.z += v.y; v.w += v.z;
    const float tot = v.w; float incl = tot;
#pragma unroll
    for (int o = 1; o < 64; o <<= 1) { const float nb = __shfl_up(incl, o); if (lane >= o) incl += nb; }
    if (lane == 63) wtot[wave] = incl;
    __syncthreads();
    float base = incl - tot;
#pragma unroll
    for (int w = 0; w < 8; ++w) if (w < wave) base += wtot[w];
    if (4 * tid < n) *(LAS f32x4*)(cb + 4 * tid) = (v + base) * (-LOG2E);
    __syncthreads();
}


__device__ __forceinline__ void fgate_stage(LAS float* Wf, const float* w_in_l, int tid) {
    for (int i = tid; i < 1024 * 2; i += NWAVES * 64) *(LAS f32x4*)(Wf + 4 * i) = *(const f32x4*)(w_in_l + (size_t)(i >> 1) * D_IN + C_FF + 4 * (i & 1));
}
__device__ __forceinline__ void fgate_row(const LAS float* rowb, const LAS float* Wf, const float* fbias, float* logf, int t, int lane) {
    float acc[8];
#pragma unroll
    for (int h = 0; h < 8; ++h) acc[h] = 0.f;
#pragma unroll 4
    for (int i = 0; i < 16; ++i) { const int k = lane + 64 * i; const float xs = rowb[k]; const f32x4 w0 = *(const LAS f32x4*)(Wf + k * 8), w1 = *(const LAS f32x4*)(Wf + k * 8 + 4);
        acc[0] += xs * w0.x; acc[1] += xs * w0.y; acc[2] += xs * w0.z; acc[3] += xs * w0.w; acc[4] += xs * w1.x; acc[5] += xs * w1.y; acc[6] += xs * w1.z; acc[7] += xs * w1.w; }
    const int b = t / SEQ, s = t % SEQ;
#pragma unroll
    for (int h = 0; h < 8; ++h) { const float z = wave_sum(acc[h]) + fbias[h]; const float ls = fminf(z, 0.f) - log1pf(__expf(-fabsf(z)));
        if (lane == h) logf[((size_t)(b * 8 + h)) * SEQ + s] = ls; }
}
typedef float f32x16_t __attribute__((ext_vector_type(16)));
typedef short bf16x8_t __attribute__((ext_vector_type(8)));
__device__ __forceinline__ void ssm_setup_group(int g, const float* lam_re, const float* lam_im, const float* log_dt, const float* b_re, const float* b_im, const float* c_re, const float* c_im, const float* dsk,
                                                bf16* MT, bf16* W2, bf16* W3, float* AL, LAS unsigned char* lds) {
    int tid = threadIdx.x; asm volatile("" : "+v"(tid));
    LAS float* apr = (LAS float*)lds;
    LAS float* api = apr + 17 * 64;
    LAS float* bbr = api + 17 * 64;
    LAS float* bbi = bbr + 1024;
    LAS float* ccr = bbi + 1024;
    LAS float* cci = ccr + 1024;
    LAS float* Kt = cci + 1024;
    const float dt = expf(log_dt[g]);
    for (int i = tid; i < 17 * 64; i += NWAVES * 64) { const int tau = i >> 6, p = i & 63; const float lr = lam_re[g * 64 + p], li = lam_im[g * 64 + p];
        const float mag = expf(lr * dt * (float)tau), ang = li * dt * (float)tau; apr[i] = mag * cosf(ang); api[i] = mag * sinf(ang); }
    for (int i = tid; i < 1024; i += NWAVES * 64) { const int p = i >> 4;
        const float lr = lam_re[g * 64 + p], li = lam_im[g * 64 + p]; const float mag = expf(lr * dt), ang = li * dt, ar = mag * cosf(ang), ai = mag * sinf(ang);
        const float er = ar - 1.f, ei = ai, den = lr * lr + li * li, qr = (er * lr + ei * li) / den, qi = (ei * lr - er * li) / den;
        const float br = b_re[(size_t)g * 1024 + i], bi = b_im[(size_t)g * 1024 + i]; bbr[i] = qr * br - qi * bi; bbi[i] = qr * bi + qi * br;
        ccr[i] = c_re[(size_t)g * 1024 + i]; cci[i] = c_im[(size_t)g * 1024 + i]; }
    __syncthreads();
    { const int tau = tid >> 5, m = (tid >> 1) & 15, n0 = (tid & 1) * 8; float acc[8];
#pragma unroll
      for (int n = 0; n < 8; ++n) acc[n] = 0.f;
      for (int p = 0; p < 64; ++p) { const float ar = apr[tau * 64 + p], ai = api[tau * 64 + p], br = bbr[p * 16 + m], bi = bbi[p * 16 + m]; const float tr = ar * br - ai * bi, ti = ar * bi + ai * br;
#pragma unroll
          for (int n = 0; n < 8; ++n) acc[n] += ccr[(n0 + n) * 64 + p] * tr - cci[(n0 + n) * 64 + p] * ti; }
#pragma unroll
      for (int n = 0; n < 8; ++n) Kt[(tau * 16 + n0 + n) * 16 + m] = acc[n] + ((tau == 0 && n0 + n == m) ? dsk[g * 16 + m] : 0.f); }
    __syncthreads();
    for (int v = tid; v < 256 * 32; v += NWAVES * 64) { const int row = v >> 5, c8 = (v & 31) * 8, i = row >> 4, n = row & 15, j = c8 >> 4, m0 = c8 & 15; float k[8];
#pragma unroll
        for (int e = 0; e < 8; ++e) k[e] = (j <= i) ? Kt[((i - j) * 16 + n) * 16 + m0 + e] : 0.f;
        v4u o; o.x = pk2(k[0], k[1]); o.y = pk2(k[2], k[3]); o.z = pk2(k[4], k[5]); o.w = pk2(k[6], k[7]);
        *(v4u*)(MT + (size_t)g * 65536 + row * 256 + c8) = o; }
    for (int v = tid; v < 128 * 32; v += NWAVES * 64) { const int q = v >> 5, c8 = (v & 31) * 8, j = c8 >> 4, m0 = c8 & 15, p = q & 63; const float ar = apr[(15 - j) * 64 + p], ai = api[(15 - j) * 64 + p]; float k[8];
#pragma unroll
        for (int e = 0; e < 8; ++e) { const float br = bbr[p * 16 + m0 + e], bi = bbi[p * 16 + m0 + e]; k[e] = q < 64 ? ar * br - ai * bi : ar * bi + ai * br; }
        v4u o; o.x = pk2(k[0], k[1]); o.y = pk2(k[2], k[3]); o.z = pk2(k[4], k[5]); o.w = pk2(k[6], k[7]);
        *(v4u*)(W2 + (size_t)g * 32768 + q * 256 + c8) = o; }
    for (int v = tid; v < 256 * 16; v += NWAVES * 64) { const int row = v >> 4, c8 = (v & 15) * 8, i = row >> 4, n = row & 15; float k[8];
#pragma unroll
        for (int e = 0; e < 8; ++e) { const int q = c8 + e, p = q & 63; const float ar = apr[(i + 1) * 64 + p], ai = api[(i + 1) * 64 + p], cr = ccr[n * 64 + p], ci = cci[n * 64 + p]; k[e] = q < 64 ? cr * ar - ci * ai : -(cr * ai + ci * ar); }
        v4u o; o.x = pk2(k[0], k[1]); o.y = pk2(k[2], k[3]); o.z = pk2(k[4], k[5]); o.w = pk2(k[6], k[7]);
        *(v4u*)(W3 + (size_t)g * 32768 + row * 128 + c8) = o; }
    if (tid < 64) { AL[g * 128 + tid] = apr[16 * 64 + tid]; AL[g * 128 + 64 + tid] = api[16 * 64 + tid]; }
    __syncthreads();
}
constexpr int SSM_RS = 528;
__device__ __forceinline__ void ssm_unit(int b, int g, const bf16* PROJ, const bf16* MT, const bf16* W2, const bf16* W3, const float* AL, bf16* GY, LAS unsigned char* lds) {
    int tid = threadIdx.x; asm volatile("" : "+v"(tid)); const int lane = tid & 63, wave = __builtin_amdgcn_readfirstlane(tid >> 6), r32 = lane & 31, hi = lane >> 5;
    LAS unsigned char* A1 = lds;
    LAS unsigned char* EB = lds + 128 * SSM_RS;
    { const bf16* up = PROJ + (size_t)b * SEQ * PP + g * 16;
#pragma unroll
      for (int k = 0; k < 8; ++k) { const int pc = tid + 512 * k, t = pc >> 1, hf = pc & 1; const v4u v = *(const v4u*)(up + (size_t)t * PP + hf * 8);
          *(LAS v4u*)(A1 + (t >> 4) * SSM_RS + ((t & 15) * 16 + hf * 8) * 2) = v; } }
    __syncthreads();
    { const int nt = wave & 3, mt0 = (wave >> 2) * 2; f32x16_t acc0, acc1;
#pragma unroll
      for (int r = 0; r < 16; ++r) { acc0[r] = 0.f; acc1[r] = 0.f; }
      const bf16* wp = W2 + (size_t)g * 32768 + (32 * nt + r32) * 256 + 8 * hi;
      const LAS unsigned char* ap = A1 + (32 * mt0 + r32) * SSM_RS + 16 * hi;
      bf16x8_t bfr[16];
#pragma unroll
      for (int ks = 0; ks < 16; ++ks) bfr[ks] = *(const bf16x8_t*)(wp + 16 * ks);
#pragma unroll
      for (int ks = 0; ks < 16; ++ks) { const bf16x8_t bf = bfr[ks];
          const bf16x8_t a0 = *(const LAS bf16x8_t*)(ap + 32 * ks), a1 = *(const LAS bf16x8_t*)(ap + 32 * SSM_RS + 32 * ks);
          acc0 = __builtin_amdgcn_mfma_f32_32x32x16_bf16(a0, bf, acc0, 0, 0, 0); acc1 = __builtin_amdgcn_mfma_f32_32x32x16_bf16(a1, bf, acc1, 0, 0, 0); }
#pragma unroll
      for (int r = 0; r < 16; ++r) { const int cr = (r & 3) + 8 * (r >> 2) + 4 * hi;
          *(LAS float*)(EB + (32 * mt0 + cr) * SSM_RS + (32 * nt + r32) * 4) = acc0[r]; *(LAS float*)(EB + (32 * mt0 + 32 + cr) * SSM_RS + (32 * nt + r32) * 4) = acc1[r]; } }
    __syncthreads();
    bf16x8_t mfr[16], wfr[8];
    { const bf16* mp = MT + (size_t)g * 65536 + (32 * wave + r32) * 256 + 8 * hi; const bf16* w3p = W3 + (size_t)g * 32768 + (32 * wave + r32) * 128 + 8 * hi;
#pragma unroll
      for (int ks = 0; ks < 16; ++ks) mfr[ks] = *(const bf16x8_t*)(mp + 16 * ks);
#pragma unroll
      for (int ks = 0; ks < 8; ++ks) wfr[ks] = *(const bf16x8_t*)(w3p + 16 * ks); }
    if (wave == 0) { const float alr = AL[g * 128 + lane], ali = AL[g * 128 + 64 + lane]; float sr = 0.f, si = 0.f;
        float er = *(const LAS float*)(EB + lane * 4), ei = *(const LAS float*)(EB + 256 + lane * 4);
        for (int c = 0; c < 128; ++c) { const int cn = c < 127 ? c + 1 : c;
            const float ern = *(const LAS float*)(EB + cn * SSM_RS + lane * 4), ein = *(const LAS float*)(EB + cn * SSM_RS + 256 + lane * 4);
            asm volatile("" ::: "memory");
            *(LAS unsigned short*)(EB + c * SSM_RS + lane * 2) = (unsigned short)f2bf(sr); *(LAS unsigned short*)(EB + c * SSM_RS + 128 + lane * 2) = (unsigned short)f2bf(si);
            const float nr = alr * sr - ali * si + er, ni = alr * si + ali * sr + ei; sr = nr; si = ni; er = ern; ei = ein; } }
    __syncthreads();
    { f32x16_t acc[4];
#pragma unroll
      for (int m = 0; m < 4; ++m)
#pragma unroll
          for (int r = 0; r < 16; ++r) acc[m][r] = 0.f;
      const LAS unsigned char* ap = A1 + r32 * SSM_RS + 16 * hi; const LAS unsigned char* sp = EB + r32 * SSM_RS + 16 * hi;
#pragma unroll
      for (int ks = 0; ks < 16; ++ks) { const bf16x8_t bf = mfr[ks];
#pragma unroll
          for (int m = 0; m < 4; ++m) { const bf16x8_t af = *(const LAS bf16x8_t*)(ap + 32 * m * SSM_RS + 32 * ks); acc[m] = __builtin_amdgcn_mfma_f32_32x32x16_bf16(af, bf, acc[m], 0, 0, 0); } }
#pragma unroll
      for (int ks = 0; ks < 8; ++ks) { const bf16x8_t bf = wfr[ks];
#pragma unroll
          for (int m = 0; m < 4; ++m) { const bf16x8_t af = *(const LAS bf16x8_t*)(sp + 32 * m * SSM_RS + 32 * ks); acc[m] = __builtin_amdgcn_mfma_f32_32x32x16_bf16(af, bf, acc[m], 0, 0, 0); } }
      const int i = 2 * wave + (r32 >> 4), n = r32 & 15; bf16* gp = GY + ((size_t)b * SEQ + i) * 512 + g * 16 + n;
#pragma unroll
      for (int m = 0; m < 4; ++m)
#pragma unroll
          for (int r = 0; r < 16; ++r) { const int c = 32 * m + (r & 3) + 8 * (r >> 2) + 4 * hi; const float y = acc[m][r]; const float u2 = 1.5957691216057308f * (y + 0.044715f * y * y * y);
              gp[(size_t)c * 16 * 512] = (bf16)f2bf(y * pg8::sigm(u2)); } }
    __syncthreads();
}
__global__ void __launch_bounds__(NWAVES * 64, 2) mk_kernel(MkArgs a) {
    extern __shared__ __attribute__((aligned(16))) unsigned char lds_raw[];
    LAS unsigned char* lds = (LAS unsigned char*)lds_raw;
    volatile LAS unsigned* MISC = (volatile LAS unsigned*)(lds + MISC_OFF);
    const int G = gridDim.x; const int vcu = (G % 8 == 0) ? ((int)blockIdx.x % 8) * (G / 8) + (int)blockIdx.x / 8 : (int)blockIdx.x;
    unsigned char* ws = a.ws;
    for (int u = threadIdx.x; u < (LDS_BYTES - MISC_OFF) / 4; u += NWAVES * 64) MISC[u] = 0u;
    __syncthreads();
    XcdBarrier bar = xcd_barrier_post((unsigned*)(ws + WS_CTL) + CW_BAR + a.bar_region * XCD_BAR_WORDS, MISC + 8);
#define PHASE_PTRS() const CAS MkArgs* akp = (const CAS MkArgs*)__builtin_amdgcn_kernarg_segment_ptr(); asm volatile("" : "+s"(akp)); const CAS MkArgs& ak = *akp;   unsigned char* wsp = ak.ws; const int Gp = opq_s((int)gridDim.x), bxp = opq_s((int)blockIdx.x); const int vcup = (Gp % 8 == 0) ? (bxp % 8) * (Gp / 8) + bxp / 8 : bxp; (void)vcup;   \
    bf16* BR = (bf16*)(wsp + WS_BR); bf16* OD = (bf16*)(wsp + WS_OD); const float* LOGF = (const float*)(wsp + WS_LOGF); \
    bf16* GY = (bf16*)(wsp + WS_GY); bf16* WGLU = (bf16*)(wsp + WS_WGLU); bf16* WB = (bf16*)(wsp + WS_WB); bf16* WO = (bf16*)(wsp + WS_WO); bf16* P = (bf16*)(wsp + WS_P); bf16* MG = (bf16*)(wsp + WS_MG); \
    float* MIX = (float*)(wsp + WS_MIX); float* GATE = (float*)(wsp + WS_ROUTE); \
    int* TOKL = (int*)(wsp + WS_TOKL); float* WL = (float*)(wsp + WS_WL); int* TSLOT = (int*)(wsp + WS_TSLOT); bf16* HB = (bf16*)(wsp + WS_H); bf16* YB = (bf16*)(wsp + WS_Y); \
    bf16* WGU = (bf16*)(wsp + WS_WG); bf16* WD = (bf16*)(wsp + WS_WD); bf16* SMT = (bf16*)(wsp + WS_SMT); bf16* SW2 = (bf16*)(wsp + WS_SW2); bf16* SW3 = (bf16*)(wsp + WS_SW3); float* SAL = (float*)(wsp + WS_SAL); (void)SMT; (void)SW2; (void)SW3; (void)SAL; \
    bf16* WIN = (bf16*)(wsp + WS_WIN); bf16* XB = (bf16*)(wsp + WS_XB); bf16* PROJ = (bf16*)(wsp + WS_PROJ); bf16* GL = (bf16*)(wsp + WS_GL); const float* ROPE = (const float*)(wsp + WS_ROPE); \
    (void)BR; (void)OD; (void)LOGF; (void)GY; (void)WGLU; (void)WB; (void)WO; (void)P; (void)MG; (void)MIX; (void)GATE; (void)TOKL; (void)WL; (void)TSLOT; (void)HB; (void)YB; (void)WGU; (void)WD; (void)WIN; (void)XB; (void)PROJ; (void)GL; (void)ROPE
    LAS int* TBL = (LAS int*)(lds + MISC_OFF + 64);
#define MOE_TABLES() do { if (threadIdx.x == 0) { int acc_ = 0; _Pragma("unroll 1") for (int e_ = 0; e_ < 16; ++e_) { const int n_ = (int)__hip_atomic_load((unsigned*)(wsp + WS_CTL) + CW_CNT + 1024 * layer + 64 * e_, RLX_AGENT); TBL[e_] = acc_; TBL[32 + e_] = n_; \
        const int nt_ = (n_ + 255) >> 8; _Pragma("unroll 1") for (int r_ = 0; r_ < nt_; ++r_) TBL[64 + acc_ + r_] = e_; acc_ += nt_; } TBL[16] = acc_; } __syncthreads(); } while (0)
    const int ph_lo = a.ph_lo, ph_hi = a.ph_hi;
#define IN(k) (opq_s(ph_lo) <= (k) && (k) < opq_s(ph_hi))
#ifdef PROBE_BAR2
#define SEAM(k) do { if ((k) == 9) break; if (IN((k) + 1) || ((k) + 1 == NPH && ph_lo == 0 && layer + 1 < a.layer_hi)) { xcd_barrier(bar); xcd_barrier(bar); } } while (0)
#else
#define SEAM(k) do { if ((k) == 9) break; if (IN((k) + 1) || ((k) + 1 == NPH && ph_lo == 0 && layer + 1 < a.layer_hi)) xcd_barrier(bar); } while (0)
#endif
    for (int layer = a.layer_lo; layer < a.layer_hi; ++layer) {
        if (IN(0)) { for (int rr_ = 0; rr_ < a.rep[0]; ++rr_) {
            PHASE_PTRS();
            int tid = threadIdx.x; asm volatile("" : "+v"(tid)); const int lane = tid & 63, wave = __builtin_amdgcn_readfirstlane(tid >> 6);
            const int gw = vcup * NWAVES + wave, NGW = Gp * NWAVES;
            if (layer == 0) {
                float* tab = (float*)(wsp + WS_ROPE);
                for (int idx = gw * 64 + lane; idx < SEQ * 32; idx += NGW * 64) { const int s = idx >> 5, i = idx & 31;
                    const float inv_freq = exp2f(-(float)(2 * i) * (13.287712379549449f / 64.0f)); const float ang = (float)s * inv_freq;
                    const double rev = (double)ang * 0.15915494309189535; const double fr = rev - __builtin_floor(rev + 0.5); const float an = (float)(fr * 6.283185307179586);
                    tab[idx] = cosf(an); tab[SEQ * 32 + idx] = sinf(an); }
                const float* x_in = ak.in[0];
                LAS float* Wf = (LAS float*)lds; LAS float* rowb = (LAS float*)(lds + 32768 + wave * 4096);
                fgate_stage(Wf, ak.in[1], tid);
                __syncthreads();
                for (int t = gw; t < M_TOK; t += NGW) {
#pragma unroll
                    for (int j = 0; j < 4; ++j) { const int c = 4 * lane + 256 * j; const f32x4 v = *(const f32x4*)(x_in + (size_t)t * DM + c); *(LAS f32x4*)(rowb + c) = v;
                        uint2 w; w.x = pk2(v.x, v.y); w.y = pk2(v.z, v.w); *(uint2*)(XB + (size_t)t * DM + c) = w; }
                    LDS_WAIT(); asm volatile("" ::: "memory");
                    fgate_row(rowb, Wf, ak.in[15], (float*)(wsp + WS_LOGF), t, lane);
                    asm volatile("" ::: "memory"); }
                __syncthreads();
            }
            LAS float* scr = (LAS float*)(lds + wave * 16384);
            for (int it = gw + (layer == 0 ? 0 : ak.conv.nitemsA); it < ak.conv.nitems; it += NGW) conv_item(ak.conv, layer, it, scr, lane);
            __syncthreads();
            if (layer == 0) for (int g = vcup; g < 32; g += Gp)
                ssm_setup_group(g, ak.in[4] + layer * 2048, ak.in[5] + layer * 2048, ak.in[6] + layer * 32, ak.in[7] + (size_t)layer * 32768, ak.in[8] + (size_t)layer * 32768, ak.in[9] + (size_t)layer * 32768, ak.in[10] + (size_t)layer * 32768,
                                ak.in[11] + layer * 512, SMT, SW2, SW3, SAL, lds);
            } SEAM(0);
        }
        if (IN(1)) { for (int rr_ = 0; rr_ < a.rep[1]; ++rr_) {
            PHASE_PTRS();
            const bf16* Ap = XB; const bf16* Bp = WIN; asm volatile("" : "+s"(Ap), "+s"(Bp));
            pg8::Gemm g; g.A = Ap; g.Bt = Bp; g.zA = 0; g.zB = 0; g.M = M_TOK; g.N = 6656; g.K = DM; g.lda = DM; g.ldb = DM; g.pad = 0;
            pg8::StaticOrder S; S.init(M_TOK, 6656, Gp, bxp);
            pg8::EpiInProj E{PROJ, GL, ROPE, C2, 0};
            pg8::gemm_phase<pg8::EpiInProj, pg8::StaticOrder, true, true>(lds, g, S, E);
            } SEAM(1);
        }
        if (IN(2)) { for (int rr_ = 0; rr_ < a.rep[2]; ++rr_) {
            PHASE_PTRS();
            for (int r11 = 0; r11 < a.rep[11]; ++r11) for (int u = vcup; u < 256; u += Gp) ssm_unit(u >> 5, u & 31, PROJ, SMT, SW2, SW3, SAL, GY, lds);
            char* shm = (char*)lds_raw;
            const attn_body::bf16* PJ = (const attn_body::bf16*)PROJ;
            for (int pi = vcup; pi < 256; pi += Gp) {
                const int row = pi >> 2, sq = pi & 3, b = row >> 3, h = row & 7;
                for (int k = 0; k < 2; ++k) { const int qb = k ? sq : 7 - sq;
                    fox_bias_scan((LAS float*)(lds + attn_body::LDS_BIAS), (LAS float*)(lds + attn_body::LDS_WS), LOGF + (size_t)(b * 8 + h) * SEQ, (qb + 1) * 256);
                    attn_body::attn_unit<8, true, 512>(b, qb, PJ + 2048 + h * 64, PJ + 2560 + h * 64, PJ + 3072 + h * 64, (attn_body::bf16*)(BR + (size_t)2 * M_TOK * 512) + h * 64, shm); }
            }
            for (int pi = 256 + vcup; pi < 768; pi += Gp) {
                const int row = (pi >> 2) - 64, sq = pi & 3, b = row >> 4, hc = (row >> 1) & 7, vh = row & 1;
                for (int k = 0; k < 2; ++k) { const int qb = k ? sq : 7 - sq;
                    attn_body::attn_unit<8, false, 1024>(b, qb, PJ + 512 + hc * 64, PJ + 1024 + hc * 64, PJ + 1536 + (hc >> 1) * 128 + vh * 64, (attn_body::bf16*)OD + (hc & 1) * 512 + (hc >> 1) * 128 + vh * 64, shm); }
            }
            } SEAM(2);
        }
        if (IN(3)) { for (int rr_ = 0; rr_ < a.rep[3]; ++rr_) {
            PHASE_PTRS();
            {   const bf16* Ap = GY; const bf16* Bp = WGLU; asm volatile("" : "+s"(Ap), "+s"(Bp));
                pg8::Gemm g; g.A = Ap; g.Bt = Bp; g.zA = 0; g.zB = 0; g.M = M_TOK; g.N = 1024; g.K = 512; g.lda = 512; g.ldb = 512; g.pad = 0;
                pg8::StaticOrder S; S.init(M_TOK, 1024, Gp, bxp);
                pg8::EpiGlu E{BR, 512, 0};
                pg8::gemm_phase<pg8::EpiGlu, pg8::StaticOrder, true, true>(lds, g, S, E); }
            {   int tid = threadIdx.x; asm volatile("" : "+v"(tid)); const int lane = tid & 63, wave = __builtin_amdgcn_readfirstlane(tid >> 6);
                const float* lam = ak.in[13] + layer * 256; const float* gnorm = ak.in[14] + layer * 512; const float lam_init = ak.lam_init[layer];
                const float s01 = wave_sum(lam[lane] * lam[64 + lane]), s23 = wave_sum(lam[128 + lane] * lam[192 + lane]);
                const float lam_full = expf(s01) - expf(s23) + lam_init;
                bf16* YD = BR + (size_t)M_TOK * 512;
                const int hh = lane >> 4, d8 = (lane & 15) * 8; const float sc = 1.f - lam_init;
                float gn[8];
#pragma unroll
                for (int e = 0; e < 8; ++e) gn[e] = gnorm[hh * 128 + d8 + e] * sc;
                const int tstr = Gp * NWAVES, tfirst = vcup * NWAVES + wave;
                v4u n0, n1; { const int tc = tfirst < M_TOK ? tfirst : 0; n0 = *(const v4u*)(OD + (size_t)tc * 1024 + hh * 128 + d8); n1 = *(const v4u*)(OD + (size_t)tc * 1024 + 512 + hh * 128 + d8); }
                for (int t = tfirst; t < M_TOK; t += tstr) {
                    const v4u c0 = n0, c1 = n1; const int tn = t + tstr;
                    if (tn < M_TOK) { n0 = *(const v4u*)(OD + (size_t)tn * 1024 + hh * 128 + d8); n1 = *(const v4u*)(OD + (size_t)tn * 1024 + 512 + hh * 128 + d8); }
                    const unsigned w0[4] = {c0.x, c0.y, c0.z, c0.w}, w1[4] = {c1.x, c1.y, c1.z, c1.w}; float av[8]; float ss = 0.f;
#pragma unroll
                    for (int e = 0; e < 4; ++e) { av[2 * e] = __builtin_bit_cast(float, w0[e] << 16) - lam_full * __builtin_bit_cast(float, w1[e] << 16); av[2 * e + 1] = __builtin_bit_cast(float, w0[e] & 0xffff0000u) - lam_full * __builtin_bit_cast(float, w1[e] & 0xffff0000u);
                        ss += av[2 * e] * av[2 * e] + av[2 * e + 1] * av[2 * e + 1]; }
#define R16_DPP(ctrl) ss += __builtin_bit_cast(float, __builtin_amdgcn_update_dpp(0, __builtin_bit_cast(int, ss), ctrl, 0xf, 0xf, true))
                    R16_DPP(0xB1); R16_DPP(0x4E); R16_DPP(0x141); R16_DPP(0x140);
#undef R16_DPP
                    const float r = rsqrtf(ss * (1.f / 128.f) + RMS_EPS);
                    v4u o; o.x = pk2(av[0] * r * gn[0], av[1] * r * gn[1]); o.y = pk2(av[2] * r * gn[2], av[3] * r * gn[3]); o.z = pk2(av[4] * r * gn[4], av[5] * r * gn[5]); o.w = pk2(av[6] * r * gn[6], av[7] * r * gn[7]);
                    *(v4u*)(YD + (size_t)t * 512 + hh * 128 + d8) = o; } }
            } SEAM(3);
        }
        if (IN(4)) { for (int rr_ = 0; rr_ < a.rep[4]; ++rr_) {
            PHASE_PTRS();
            const bf16* Ap = BR; const bf16* Bp = WB; asm volatile("" : "+s"(Ap), "+s"(Bp));
            pg8::Gemm g; g.A = Ap; g.Bt = Bp; g.zA = (long)M_TOK * 512 * 2; g.zB = 1024L * 512 * 2; g.M = M_TOK; g.N = 1024; g.K = 512; g.lda = 512; g.ldb = 512; g.pad = 0;
            pg8::BatchOrder S; S.init(M_TOK, 1024, 3, Gp, bxp);
            pg8::EpiGatedChain E{MG, GL};
            pg8::gemm_phase<pg8::EpiGatedChain, pg8::BatchOrder, true, true>(lds, g, S, E);
            } SEAM(4);
        }
        if (IN(6)) { for (int rr_ = 0; rr_ < a.rep[6]; ++rr_) {
            PHASE_PTRS();
            const bf16* Ap = MG; const bf16* Bp = WO; asm volatile("" : "+s"(Ap), "+s"(Bp));
            pg8::Gemm g; g.A = Ap; g.Bt = Bp; g.zA = 0; g.zB = 0; g.M = M_TOK; g.N = DM; g.K = DM; g.lda = DM; g.ldb = DM; g.pad = 0;
            pg8::StaticOrder S; S.init(M_TOK, DM, Gp, bxp);
            pg8::EpiStoreF32 E{MIX, DM, 0};
            pg8::gemm_phase<pg8::EpiStoreF32, pg8::StaticOrder, true, true>(lds, g, S, E);
            } SEAM(6);
        }
        if (IN(7)) { for (int rr_ = 0; rr_ < a.rep[7]; ++rr_) {
            PHASE_PTRS();
            int tid = threadIdx.x; asm volatile("" : "+v"(tid)); const int lane = tid & 63, wave = __builtin_amdgcn_readfirstlane(tid >> 6);
            const bool fake = rr_ + 1 < a.rep[7];
            float* outp = fake ? (float*)(wsp + WS_PROJ) : ak.out; bf16* XBp = fake ? (bf16*)(wsp + WS_PROJ + 64 * MiB) : XB; int* TOKLp = fake ? (int*)(wsp + WS_OD) : TOKL; float* WLp = fake ? (float*)(wsp + WS_OD + 2 * MiB) : WL; int* TSLOTp = fake ? (int*)(wsp + WS_OD + 4 * MiB) : TSLOT; const int cl = fake ? 4 + layer : layer;
            const float* xin = layer == 0 ? ak.in[0] : ak.out;
            const float* w_g = ak.in[18] + (size_t)layer * DM * 4; const float* w_e = ak.in[20] + (size_t)layer * DM * 16;
            LAS float* Wl = (LAS float*)lds;
            LAS float* rowb = (LAS float*)(lds + 81920 + wave * 4096);
            LAS int* lcnt = (LAS int*)(lds + 81920 + 8 * 4096);
            LAS int* rec = lcnt + 32;
            if (tid < 32) lcnt[tid] = 0;
            int nrow = 0;
            for (int i = tid; i < 1024 * 4; i += NWAVES * 64) Wl[(i >> 2) * 20 + (i & 3)] = w_g[i];
            for (int i = tid; i < 1024 * 16; i += NWAVES * 64) Wl[(i >> 4) * 20 + 4 + (i & 15)] = w_e[i];
            __syncthreads();
            const float* lg_ = ak.in[16] + layer * DM; const float* lb_ = ak.in[17] + layer * DM; const float* b_g = ak.in[19] + layer * 4; const float* b_e = ak.in[21] + layer * 16;
            f32x4 nx[4], nm[4];
            { const int t0 = vcup * NWAVES + wave;
#pragma unroll
              for (int j = 0; j < 4; ++j) { const size_t o = (size_t)(t0 < M_TOK ? t0 : 0) * DM + 4 * lane + 256 * j; nx[j] = *(const f32x4*)(xin + o); nm[j] = *(const f32x4*)(MIX + o); } }
            for (int t = vcup * NWAVES + wave; t < M_TOK; t += Gp * NWAVES) {
                f32x4 v[4]; float s = 0.f;
#pragma unroll
                for (int j = 0; j < 4; ++j) { v[j] = ALPHA * nx[j] + nm[j]; s += (v[j].x + v[j].y) + (v[j].z + v[j].w); }
                { const int tn = t + Gp * NWAVES;
                  if (tn < M_TOK) {
#pragma unroll
                      for (int j = 0; j < 4; ++j) { const size_t o = (size_t)tn * DM + 4 * lane + 256 * j; nx[j] = *(const f32x4*)(xin + o); nm[j] = *(const f32x4*)(MIX + o); } } }
                const float mean = wave_sum(s) * (1.f / DM); float s2 = 0.f;
#pragma unroll
                for (int j = 0; j < 4; ++j) { v[j] = v[j] - mean; s2 += (v[j].x * v[j].x + v[j].y * v[j].y) + (v[j].z * v[j].z + v[j].w * v[j].w); }
                const float rstd = rsqrtf(wave_sum(s2) * (1.f / DM) + LN_EPS);
#pragma unroll
                for (int j = 0; j < 4; ++j) { const int c = 4 * lane + 256 * j; const size_t o = (size_t)t * DM + c; v[j] = v[j] * rstd * *(const f32x4*)(lg_ + c) + *(const f32x4*)(lb_ + c);
                    *(f32x4*)(outp + o) = v[j]; uint2 w; w.x = pk2(v[j].x, v[j].y); w.y = pk2(v[j].z, v[j].w); *(uint2*)(XBp + o) = w; *(LAS f32x4*)(rowb + c) = v[j]; }
                LDS_WAIT(); asm volatile("" ::: "memory");
                float lg[20];
#pragma unroll
                for (int q = 0; q < 20; ++q) lg[q] = 0.f;
#pragma unroll 2
                for (int i = 0; i < 16; ++i) { const int k = lane + 64 * i; const float xs = rowb[k]; const LAS f32x4* wp = (const LAS f32x4*)(Wl + k * 20);
#pragma unroll
                    for (int q = 0; q < 5; ++q) { const f32x4 w = wp[q]; lg[4 * q] += xs * w.x; lg[4 * q + 1] += xs * w.y; lg[4 * q + 2] += xs * w.z; lg[4 * q + 3] += xs * w.w; } }
#pragma unroll
                for (int q = 0; q < 20; ++q) lg[q] = wave_sum(lg[q]) + (q < 4 ? b_g[q] : b_e[q - 4]);
                int gi = 0; float gm = lg[0];
#pragma unroll
                for (int q = 1; q < 4; ++q) if (lg[q] > gm) { gm = lg[q]; gi = q; }
                float den = 0.f;
#pragma unroll
                for (int q = 0; q < 4; ++q) den += __expf(lg[q] - gm);
                const float gp = 1.f / den;
                float sel[4];
#pragma unroll
                for (int q = 0; q < 4; ++q) sel[q] = gi == 0 ? lg[4 + q] : gi == 1 ? lg[8 + q] : gi == 2 ? lg[12 + q] : lg[16 + q];
                int i0 = 0; float v0 = sel[0];
#pragma unroll
                for (int q = 1; q < 4; ++q) if (sel[q] > v0) { v0 = sel[q]; i0 = q; }
                int i1 = -1; float v1 = -INFINITY;
#pragma unroll
                for (int q = 0; q < 4; ++q) if (q != i0 && sel[q] > v1) { v1 = sel[q]; i1 = q; }
                const float e1 = __expf(v1 - v0), w0 = gp / (1.f + e1), w1 = gp * e1 / (1.f + e1);
                const int E0 = gi * 4 + i0, E1 = gi * 4 + i1;
                if (lane < 16) GATE[(size_t)t * 16 + lane] = (lane == E0 ? w0 : 0.f) + (lane == E1 ? w1 : 0.f);
                if (lane == 0) {
                    const int r0 = (int)__hip_atomic_fetch_add((LAS unsigned*)lcnt + E0, 1u, __ATOMIC_RELAXED, __HIP_MEMORY_SCOPE_WORKGROUP), r1 = (int)__hip_atomic_fetch_add((LAS unsigned*)lcnt + E1, 1u, __ATOMIC_RELAXED, __HIP_MEMORY_SCOPE_WORKGROUP);
                    LAS int* rc = rec + (wave * 16 + nrow) * 8; rc[0] = t; rc[1] = E0; rc[2] = E1; rc[3] = r0; rc[4] = r1; rc[5] = __float_as_int(w0); rc[6] = __float_as_int(w1); }
                ++nrow;
                asm volatile("" ::: "memory");
            }
            __syncthreads();
            if (tid < 16) { const int n = lcnt[tid]; lcnt[16 + tid] = n ? (int)__hip_atomic_fetch_add((unsigned*)(wsp + WS_CTL) + CW_CNT + 1024 * cl + 64 * tid, (unsigned)n, RLX_AGENT) : 0; }
            __syncthreads();
            if (lane == 0) for (int k = 0; k < nrow; ++k) { const LAS int* rc = rec + (wave * 16 + k) * 8; const int t = rc[0], E0 = rc[1], E1 = rc[2], p0 = lcnt[16 + E0] + rc[3], p1 = lcnt[16 + E1] + rc[4];
                TOKLp[E0 * 16384 + p0] = t; WLp[E0 * 16384 + p0] = __int_as_float(rc[5]); TOKLp[E1 * 16384 + p1] = t; WLp[E1 * 16384 + p1] = __int_as_float(rc[6]);
                TSLOTp[2 * t] = (E0 << 20) | p0; TSLOTp[2 * t + 1] = (E1 << 20) | p1; }
            } SEAM(7);
        }
        if (IN(8)) { for (int rr_ = 0; rr_ < a.rep[8]; ++rr_) {
            PHASE_PTRS();
            MOE_TABLES();
            const int NT = __builtin_amdgcn_readfirstlane(TBL[16]);
            if (vcup < NT) {
                pg8::MoeTables T{TBL, TBL + 32};
                {   const bf16* Ap = XB; const bf16* Bp = WGU; asm volatile("" : "+s"(Ap), "+s"(Bp));
                    pg8::Gemm g; g.A = Ap; g.Bt = Bp; g.zA = 0; g.zB = 512L * 1024 * 2; g.M = 0; g.N = 512; g.K = DM; g.lda = DM; g.ldb = DM; g.pad = 0;
                    pg8::MoeTileOrder<2> S{T, TOKL, vcup, Gp, DM * 2};
                    pg8::EpiMoeUp E{HB, WL, T};
                    pg8::gemm_phase<pg8::EpiMoeUp, pg8::MoeTileOrder<2>, true, true, true>(lds, g, S, E); }
                asm volatile("s_waitcnt vmcnt(0)" ::: "memory");
                if (threadIdx.x == 0) { __builtin_amdgcn_fence(__ATOMIC_ACQUIRE, "agent"); asm volatile("s_waitcnt vmcnt(0)" ::: "memory"); }
                __syncthreads();
                {   const bf16* Ap = HB; const bf16* Bp = WD; asm volatile("" : "+s"(Ap), "+s"(Bp));
                    pg8::Gemm g; g.A = Ap; g.Bt = Bp; g.zA = 0; g.zB = 256 * 2; g.M = 0; g.N = DM; g.K = 256; g.lda = 256; g.ldb = 4096; g.pad = 0;
                    pg8::MoeTileOrder<4> S{T, TOKL, vcup, Gp, 0};
                    pg8::EpiStoreBf16 E{YB, DM, 0, 0};
                    pg8::gemm_phase<pg8::EpiStoreBf16, pg8::MoeTileOrder<4>, true, true>(lds, g, S, E); }
            } else if (layer + 1 < DEPTH && rr_ == 0) {
                int tid = threadIdx.x; asm volatile("" : "+v"(tid)); const int lane = tid & 63, wave = __builtin_amdgcn_readfirstlane(tid >> 6);
                const int idle = vcup - NT, nidle = Gp - NT;
                LAS float* scr = (LAS float*)(lds + wave * 16384);
                for (int it = idle * NWAVES + wave; it < ak.conv.nitemsA; it += nidle * NWAVES) conv_item(ak.conv, layer + 1, it, scr, lane);
                __syncthreads();
                for (int g = idle; g < 32; g += nidle)
                    ssm_setup_group(g, ak.in[4] + (layer + 1) * 2048, ak.in[5] + (layer + 1) * 2048, ak.in[6] + (layer + 1) * 32, ak.in[7] + (size_t)(layer + 1) * 32768, ak.in[8] + (size_t)(layer + 1) * 32768, ak.in[9] + (size_t)(layer + 1) * 32768,
                                    ak.in[10] + (size_t)(layer + 1) * 32768, ak.in[11] + (layer + 1) * 512, SMT, SW2, SW3, SAL, lds);
            }
            } SEAM(8);
        }
        if (IN(10)) { for (int rr_ = 0; rr_ < a.rep[10]; ++rr_) {
            PHASE_PTRS();
            MOE_TABLES();
            int tid = threadIdx.x; asm volatile("" : "+v"(tid)); const int lane = tid & 63, wave = __builtin_amdgcn_readfirstlane(tid >> 6);
            const bool fake = rr_ + 1 < a.rep[10]; float* outp = fake ? (float*)(wsp + WS_GL) : ak.out; bf16* XBp = fake ? (bf16*)(wsp + WS_GL + 64 * MiB) : XB; float* LOGFp = fake ? (float*)(wsp + WS_OD) : (float*)(wsp + WS_LOGF);
            const float* lg_ = ak.in[25] + layer * DM; const float* lb_ = ak.in[26] + layer * DM;
            const bool nextl = layer + 1 < DEPTH;
            LAS float* Wf = (LAS float*)lds; LAS float* rowb = (LAS float*)(lds + 32768 + wave * 4096);
            if (nextl) { fgate_stage(Wf, ak.in[1] + (size_t)(layer + 1) * DM * D_IN, tid); __syncthreads(); }
            const int tstr = Gp * NWAVES, tfirst = vcup * NWAVES + wave;
            uint2 na[4], nb[4]; f32x4 nxr[4];
            int ns0 = 0, ns1 = 0;
            { const int tc = tfirst < M_TOK ? tfirst : 0; const int s0 = TSLOT[2 * tc], s1 = TSLOT[2 * tc + 1];
              const bf16* y0 = YB + (size_t)(TBL[s0 >> 20] * 256 + (s0 & 0xfffff)) * DM; const bf16* y1 = YB + (size_t)(TBL[s1 >> 20] * 256 + (s1 & 0xfffff)) * DM;
#pragma unroll
              for (int j = 0; j < 4; ++j) { const int c = 4 * lane + 256 * j; na[j] = *(const uint2*)(y0 + c); nb[j] = *(const uint2*)(y1 + c); nxr[j] = *(const f32x4*)(ak.out + (size_t)tc * DM + c); }
              const int t1 = tfirst + tstr; if (t1 < M_TOK) { ns0 = TSLOT[2 * t1]; ns1 = TSLOT[2 * t1 + 1]; } }
            for (int t = tfirst; t < M_TOK; t += tstr) {
                f32x4 v[4]; float s = 0.f;
#pragma unroll
                for (int j = 0; j < 4; ++j) { const uint2 p0 = na[j], p1 = nb[j];
                    f32x4 ff; ff.x = __builtin_bit_cast(float, p0.x << 16) + __builtin_bit_cast(float, p1.x << 16); ff.y = __builtin_bit_cast(float, p0.x & 0xffff0000u) + __builtin_bit_cast(float, p1.x & 0xffff0000u);
                    ff.z = __builtin_bit_cast(float, p0.y << 16) + __builtin_bit_cast(float, p1.y << 16); ff.w = __builtin_bit_cast(float, p0.y & 0xffff0000u) + __builtin_bit_cast(float, p1.y & 0xffff0000u);
                    v[j] = ALPHA * nxr[j] + ff; s += (v[j].x + v[j].y) + (v[j].z + v[j].w); }
                { const int tn = t + tstr;
                  if (tn < M_TOK) { const bf16* y0 = YB + (size_t)(TBL[ns0 >> 20] * 256 + (ns0 & 0xfffff)) * DM; const bf16* y1 = YB + (size_t)(TBL[ns1 >> 20] * 256 + (ns1 & 0xfffff)) * DM;
#pragma unroll
                      for (int j = 0; j < 4; ++j) { const int c = 4 * lane + 256 * j; na[j] = *(const uint2*)(y0 + c); nb[j] = *(const uint2*)(y1 + c); nxr[j] = *(const f32x4*)(ak.out + (size_t)tn * DM + c); }
                      const int t2 = tn + tstr; if (t2 < M_TOK) { ns0 = TSLOT[2 * t2]; ns1 = TSLOT[2 * t2 + 1]; } } }
                const float mean = wave_sum(s) * (1.f / DM); float s2 = 0.f;
#pragma unroll
                for (int j = 0; j < 4; ++j) { v[j] = v[j] - mean; s2 += (v[j].x * v[j].x + v[j].y * v[j].y) + (v[j].z * v[j].z + v[j].w * v[j].w); }
                const float rstd = rsqrtf(wave_sum(s2) * (1.f / DM) + LN_EPS);
#pragma unroll
                for (int j = 0; j < 4; ++j) { const int c = 4 * lane + 256 * j; const size_t o = (size_t)t * DM + c; v[j] = v[j] * rstd * *(const f32x4*)(lg_ + c) + *(const f32x4*)(lb_ + c);
                    *(f32x4*)(outp + o) = v[j]; uint2 w; w.x = pk2(v[j].x, v[j].y); w.y = pk2(v[j].z, v[j].w); *(uint2*)(XBp + o) = w; if (nextl) *(LAS f32x4*)(rowb + c) = v[j]; }
                if (nextl) { LDS_WAIT(); asm volatile("" ::: "memory"); fgate_row(rowb, Wf, ak.in[15] + (layer + 1) * 8, LOGFp, t, lane); asm volatile("" ::: "memory"); }
            }
            } SEAM(10);
        }
    }
#undef IN
#undef SEAM
}


template <class Epi> static void launch_gemm(hipStream_t st, int grid, const bf16* A, int lda, const bf16* Bt, int ldb, int M, int N, int K, Epi E) {
    static bool attr = false;
    if (!attr) { (void)hipFuncSetAttribute((const void*)gemm_kernel<Epi>, hipFuncAttributeMaxDynamicSharedMemorySize, pg8::STAGE_BYTES); attr = true; }
    pg8::Gemm g{}; g.A = A; g.Bt = Bt; g.M = M; g.N = N; g.K = K; g.lda = lda; g.ldb = ldb; g.pad = 0; g.zA = 0; g.zB = 0;
    hipLaunchKernelGGL(gemm_kernel<Epi>, dim3(grid), dim3(512), pg8::STAGE_BYTES, st, g, E);
}
static void add_job(ConvArgs& A, const float* src, long lstride, bf16* dst, int K, int N, int ld_src, int col0, int nbatch, long sbs, long dbs, int dst_ld, int mode) {
    ConvJob& J = A.j[A.njobs]; J.src = src; J.dst = dst; J.src_lstride = lstride; J.src_bstride = sbs; J.dst_bstride = dbs; J.K = K; J.N = N; J.ld_src = ld_src; J.col0 = col0; J.nbatch = nbatch; J.dst_ld = dst_ld; J.item0 = A.nitems; J.mode = mode;
    A.nitems += nbatch * (K / 64) * (N / 32); A.njobs++;
}

extern "C" void kernel_launch(void* const* d_in, const int* in_sizes, int n_in, void* d_out, int out_size, void* d_ws, size_t ws_size, hipStream_t stream) {
    if (n_in != 27 || in_sizes[0] != M_TOK * DM || out_size != M_TOK * DM || ws_size < WS_END) { fprintf(stderr, "kernel_launch: unexpected shapes (n_in %d, ws %zu < %zu?)\n", n_in, ws_size, (size_t)WS_END); return; }
    const float* x_in = (const float*)d_in[0]; const float* w_in = (const float*)d_in[1]; const float* w_branch = (const float*)d_in[2]; const float* w_out = (const float*)d_in[3];
    const float* lam_re = (const float*)d_in[4]; const float* lam_im = (const float*)d_in[5]; const float* log_dt = (const float*)d_in[6];
    const float* b_re = (const float*)d_in[7]; const float* b_im = (const float*)d_in[8]; const float* c_re = (const float*)d_in[9]; const float* c_im = (const float*)d_in[10];
    const float* ssm_d = (const float*)d_in[11]; const float* w_glu = (const float*)d_in[12]; const float* diff_lam = (const float*)d_in[13]; const float* diff_g = (const float*)d_in[14];
    const float* fox_b = (const float*)d_in[15]; const float* ln1_g = (const float*)d_in[16]; const float* ln1_b = (const float*)d_in[17];
    const float* mw_g = (const float*)d_in[18]; const float* mb_g = (const float*)d_in[19]; const float* mw_e = (const float*)d_in[20]; const float* mb_e = (const float*)d_in[21];
    const float* mw_gate = (const float*)d_in[22]; const float* mw_up = (const float*)d_in[23]; const float* mw_down = (const float*)d_in[24]; const float* ln2_g = (const float*)d_in[25]; const float* ln2_b = (const float*)d_in[26];
    unsigned char* ws = (unsigned char*)d_ws; float* out = (float*)d_out;
    bf16* WIN = (bf16*)(ws + WS_WIN); bf16* WB = (bf16*)(ws + WS_WB); bf16* WO = (bf16*)(ws + WS_WO); bf16* WGLU = (bf16*)(ws + WS_WGLU); bf16* WG = (bf16*)(ws + WS_WG); bf16* WU = (bf16*)(ws + WS_WU); bf16* WD = (bf16*)(ws + WS_WD);
    float* ROPE = (float*)(ws + WS_ROPE); bf16* XB = (bf16*)(ws + WS_XB); bf16* PROJ = (bf16*)(ws + WS_PROJ); bf16* GL = (bf16*)(ws + WS_GL); bf16* GY = (bf16*)(ws + WS_GY); bf16* BR = (bf16*)(ws + WS_BR);
    bf16* OD = (bf16*)(ws + WS_OD); float* CB = (float*)(ws + WS_CB); float* LOGF = (float*)(ws + WS_LOGF); float* GATE = (float*)(ws + WS_ROUTE);
    bf16* P = (bf16*)(ws + WS_P); bf16* MG = (bf16*)(ws + WS_MG); float* MIX = (float*)(ws + WS_MIX); bf16* HG = (bf16*)(ws + WS_HG); bf16* HU = (bf16*)(ws + WS_HU); float* FF = (float*)(ws + WS_FF);
    static int grid = 0;
    if (!grid) {
        int dev = 0, cus = 0; (void)hipGetDevice(&dev); (void)hipDeviceGetAttribute(&cus, hipDeviceAttributeMultiprocessorCount, dev);
        (void)hipFuncSetAttribute((const void*)mk_kernel, hipFuncAttributeMaxDynamicSharedMemorySize, LDS_BYTES);
        grid = cus > 0 ? cus : 256;
    }
    const int G = grid;
    (void)hipMemsetAsync(ws + WS_CTL, 0, CTL_ZERO_BYTES, stream);
    MkArgs a; memset(&a, 0, sizeof(a));
    for (int i = 0; i < 27; ++i) a.in[i] = (const float*)d_in[i];
    a.out = out; a.ws = ws;
    for (int l = 0; l < DEPTH; ++l) a.lam_init[l] = (float)(0.8 - 0.6 * exp(-0.3 * (double)l));
    {   ConvArgs& A = a.conv;
        add_job(A, w_in, (long)DM * D_IN, WIN, 1024, 512, D_IN, 0, 1, 0, 0, 1024, 0);
        add_job(A, w_in, (long)DM * D_IN, WIN + (size_t)512 * 1024, 1024, 1024, D_IN, 512, 1, 0, 0, 1024, 1);
        add_job(A, w_in, (long)DM * D_IN, WIN + (size_t)1536 * 1024, 1024, 2048, D_IN, 1536, 1, 0, 0, 1024, 0);
        add_job(A, w_in, (long)DM * D_IN, WIN + (size_t)3584 * 1024, 1024, 3072, D_IN, C_GL, 1, 0, 0, 1024, 0);
        add_job(A, w_branch, 3L * 512 * 1024, WB, 512, 1024, 1024, 0, 3, 512 * 1024, 1024 * 512, 512, 0);
        add_job(A, w_out, 1024L * 1024, WO, 1024, 1024, 1024, 0, 1, 0, 0, 1024, 0);
        add_job(A, w_glu, 512L * 1024, WGLU, 512, 1024, 1024, 0, 1, 0, 0, 512, 2);
        A.nitemsA = A.nitems;
        add_job(A, mw_gate, 16L * 1024 * 256, WG, 1024, 256, 256, 0, 16, 1024 * 256, 512 * 1024, 1024, 3);
        add_job(A, mw_up, 16L * 1024 * 256, WG, 1024, 256, 256, 0, 16, 1024 * 256, 512 * 1024, 1024, 4);
        add_job(A, mw_down, 16L * 256 * 1024, WD, 4096, 1024, 1024, 0, 1, 0, 0, 4096, 0); }
    for (int k = 0; k < 12; ++k) a.rep[k] = 1;
#ifdef PROBE_REP
    { const int pr[] = {PROBE_REP}; for (unsigned k = 0; k < sizeof(pr) / sizeof(int); ++k) a.rep[pr[k]] = 2; }
#endif
    a.layer_lo = 0; a.layer_hi = DEPTH; a.ph_lo = 0; a.ph_hi = NPH; a.bar_region = 0;
    hipLaunchKernelGGL(mk_kernel, dim3(G), dim3(NWAVES * 64), LDS_BYTES, stream, a);
}
```
